# Optimizing an MI355X kernel written in HIP

```python
import jax, jax.numpy as jnp
from jax import lax
import numpy as np

D_MODEL = 1024
BATCH = 16
SEQ = 4096
DEPTH = 1

PLE_DIM = 256
HG_WIDTH = D_MODEL // 2
HG_KDIM = 128
HG_HEADS = HG_WIDTH // HG_KDIM
HG_VDIM = HG_WIDTH // HG_HEADS
HG_CHUNK = 64
FOX_WIDTH = D_MODEL // 2
FOX_HDIM = 64
FOX_HEADS = FOX_WIDTH // FOX_HDIM
FOX_BLOCK = 128
D_FF = 4 * D_MODEL
N_IN = 4 * HG_WIDTH + 3 * FOX_WIDTH + FOX_HEADS + 2 * D_MODEL
LN_EPS = 1e-5
RMS_EPS = 1e-6
DEEPNORM_ALPHA = (2.0 * DEPTH) ** 0.25
DEEPNORM_BETA = (8.0 * DEPTH) ** -0.25

kernel_name = "hybrid_hgrn2_fox_deepnorm_block"


def layer_norm(x, g, b):
    xf = x.astype(jnp.float32)
    mu = jnp.mean(xf, axis=-1, keepdims=True)
    var = jnp.mean(jnp.square(xf - mu), axis=-1, keepdims=True)
    y = (xf - mu) * lax.rsqrt(var + LN_EPS)
    return (y * g.astype(jnp.float32) + b.astype(jnp.float32)).astype(x.dtype)


def hgrn2_lower_bound(lb_logits, layer):
    probs = jax.nn.softmax(lb_logits.astype(jnp.float32), axis=0)
    return jnp.cumsum(probs, axis=0)[layer]


def _hgrn2_chunk_step(state, chunk):
    q_c, k_c, v_c, g_c = chunk
    C = q_c.shape[2]
    b = jnp.cumsum(g_c, axis=2)
    causal = jnp.tril(jnp.ones((C, C), dtype=bool))[:, :, None]
    diff = b[:, :, :, None, :] - b[:, :, None, :, :]
    decay = jnp.exp(jnp.where(causal, diff, -jnp.inf))
    scores = jnp.einsum('bhtk,bhtsk,bhsk->bhts', q_c, decay, k_c)
    o = (jnp.einsum('bhts,bhsv->bhtv', scores, v_c)
         + jnp.einsum('bhtk,bhkv->bhtv', q_c * jnp.exp(b), state))
    b_last = b[:, :, -1:, :]
    new_state = (jnp.exp(b_last[:, :, 0, :])[..., None] * state
                 + jnp.einsum('bhsk,bhsv->bhkv', k_c * jnp.exp(b_last - b), v_c))
    return new_state, o


def hgrn2_branch(q_lin, f_lin, i_lin, og_lin, lb, norm_g):
    B, S, _ = q_lin.shape
    n_chunks = S // HG_CHUNK
    q = jax.nn.silu(q_lin.astype(jnp.float32))
    f = lb + (1.0 - lb) * jax.nn.sigmoid(f_lin.astype(jnp.float32))
    log_f = jnp.log(f)
    k = 1.0 - f
    v = i_lin.astype(jnp.float32)

    def to_chunks(t, d):
        return t.reshape(B, n_chunks, HG_CHUNK, HG_HEADS, d).transpose(1, 0, 3, 2, 4)

    xs = (to_chunks(q, HG_KDIM), to_chunks(k, HG_KDIM), to_chunks(v, HG_VDIM), to_chunks(log_f, HG_KDIM))
    state0 = jnp.zeros((B, HG_HEADS, HG_KDIM, HG_VDIM), jnp.float32)
    _, o = lax.scan(_hgrn2_chunk_step, state0, xs)
    o = o.transpose(1, 0, 3, 2, 4).reshape(B, S, HG_HEADS, HG_VDIM)
    o = o * lax.rsqrt(jnp.mean(jnp.square(o), axis=-1, keepdims=True) + RMS_EPS)
    o = o.reshape(B, S, HG_WIDTH) * norm_g.astype(jnp.float32) * jax.nn.silu(og_lin.astype(jnp.float32))
    return o.astype(q_lin.dtype)


def fox_branch(q_lin, k_lin, v_lin, f_lin, f_bias):
    B, S, _ = q_lin.shape
    def heads(t):
        return t.reshape(B, S, FOX_HEADS, FOX_HDIM).transpose(0, 2, 1, 3)
    q, k, v = heads(q_lin), heads(k_lin), heads(v_lin)
    log_f = jax.nn.log_sigmoid(f_lin.astype(jnp.float32) + f_bias.astype(jnp.float32))
    c = jnp.cumsum(log_f.transpose(0, 2, 1), axis=-1)
    scale = FOX_HDIM ** -0.5
    outs = []
    for blk in range(S // FOX_BLOCK):
        start, end = blk * FOX_BLOCK, (blk + 1) * FOX_BLOCK
        qb = q[:, :, start:end]
        kb, vb = k[:, :, :end], v[:, :, :end]
        logits = jnp.einsum('bhqd,bhkd->bhqk', qb, kb).astype(jnp.float32) * scale
        logits = logits + (c[:, :, start:end, None] - c[:, :, None, :end])
        q_pos = jnp.arange(start, end)
        k_pos = jnp.arange(end)
        mask = k_pos[None, :] <= q_pos[:, None]
        probs = jax.nn.softmax(jnp.where(mask, logits, -jnp.inf), axis=-1)
        outs.append(jnp.einsum('bhqk,bhkd->bhqd', probs.astype(vb.dtype), vb))
    o = jnp.concatenate(outs, axis=2)
    return o.transpose(0, 2, 1, 3).reshape(B, S, FOX_WIDTH)


def setup_inputs(seed: int = 0) -> dict:
    key = jax.random.key(seed)
    ks = jax.random.split(key, 20)
    f32 = jnp.float32
    nrm = lambda k, shape, s: jax.random.normal(k, shape, f32) * s
    beta = DEEPNORM_BETA
    return {
        "x": nrm(ks[0], (BATCH, SEQ, D_MODEL), 1.0),
        "p": nrm(ks[1], (DEPTH, BATCH, SEQ, PLE_DIM), 1.0),
        "ln0_g": 1.0 + nrm(ks[2], (D_MODEL,), 0.02),
        "ln0_b": nrm(ks[3], (D_MODEL,), 0.02),
        "w_in": nrm(ks[4], (DEPTH, D_MODEL, N_IN), D_MODEL ** -0.5),
        "hg_lb": nrm(ks[5], (DEPTH + 1, HG_WIDTH), 1.0),
        "hg_norm_g": 1.0 + nrm(ks[6], (DEPTH, HG_WIDTH), 0.02),
        "fox_fb": jnp.linspace(1.0, 4.0, FOX_HEADS, dtype=f32)[None, :] + nrm(ks[7], (DEPTH, FOX_HEADS), 0.1),
        "w_a": nrm(ks[8], (DEPTH, HG_WIDTH, D_MODEL), beta * HG_WIDTH ** -0.5),
        "w_b": nrm(ks[9], (DEPTH, FOX_WIDTH, D_MODEL), beta * FOX_WIDTH ** -0.5),
        "w_o": nrm(ks[10], (DEPTH, D_MODEL, D_MODEL), beta * D_MODEL ** -0.5),
        "ln1_g": 1.0 + nrm(ks[11], (DEPTH, D_MODEL), 0.02),
        "ln1_b": nrm(ks[12], (DEPTH, D_MODEL), 0.02),
        "w_ff1": nrm(ks[13], (DEPTH, D_MODEL, D_FF), beta * D_MODEL ** -0.5),
        "w_ff2": nrm(ks[14], (DEPTH, D_FF, D_MODEL), beta * D_FF ** -0.5),
        "w_pg": nrm(ks[15], (DEPTH, D_MODEL, D_MODEL), D_MODEL ** -0.5),
        "w_p": nrm(ks[16], (DEPTH, PLE_DIM, D_MODEL), beta * PLE_DIM ** -0.5),
        "ln2_g": 1.0 + nrm(ks[17], (DEPTH, D_MODEL), 0.02),
        "ln2_b": nrm(ks[18], (DEPTH, D_MODEL), 0.02),
    }


def reference(x, p, ln0_g, ln0_b, w_in, hg_lb, hg_norm_g, fox_fb, w_a, w_b, w_o,
              ln1_g, ln1_b, w_ff1, w_ff2, w_pg, w_p, ln2_g, ln2_b):
    sizes = [HG_WIDTH] * 4 + [FOX_WIDTH] * 3 + [FOX_HEADS] + [D_MODEL] * 2
    split_at = [int(s) for s in np.cumsum(sizes)[:-1]]
    h = layer_norm(x, ln0_g, ln0_b)
    for i in range(DEPTH):
        proj = jnp.einsum('bsd,dn->bsn', h, w_in[i])
        (hg_q, hg_f, hg_i, hg_g, fx_q, fx_k, fx_v, fx_f, gate_a, gate_b) = jnp.split(proj, split_at, axis=-1)
        lb = hgrn2_lower_bound(hg_lb, i)
        y_a = hgrn2_branch(hg_q, hg_f, hg_i, hg_g, lb, hg_norm_g[i])
        y_b = fox_branch(fx_q, fx_k, fx_v, fx_f, fox_fb[i])
        merged = (jax.nn.sigmoid(gate_a) * jnp.einsum('bsc,cd->bsd', y_a, w_a[i])
                  + jax.nn.sigmoid(gate_b) * jnp.einsum('bsc,cd->bsd', y_b, w_b[i]))
        mix = jnp.einsum('bsd,de->bse', merged, w_o[i])
        h = layer_norm(DEEPNORM_ALPHA * h + mix, ln1_g[i], ln1_b[i])
        ff = jnp.einsum('bsf,fd->bsd', jnp.square(jax.nn.relu(jnp.einsum('bsd,df->bsf', h, w_ff1[i]))), w_ff2[i])
        ple = jax.nn.sigmoid(jnp.einsum('bsd,de->bse', h, w_pg[i])) * jnp.einsum('bsp,pd->bsd', p[i], w_p[i])
        h = layer_norm(DEEPNORM_ALPHA * h + ff + ple, ln2_g[i], ln2_b[i])
    return h
```

```cpp
#include <hip/hip_runtime.h>
#include <hip/hip_cooperative_groups.h>
#include <cstdio>
#include <cstdint>
namespace cg = cooperative_groups;
#define PG8_AUX 0
#define PROBE_ACT 4
namespace pg8 {
#define PG8_LAS __attribute__((address_space(3)))
typedef unsigned short bf16_t;
typedef short bf16x8 __attribute__((ext_vector_type(8)));
typedef float f32x4 __attribute__((ext_vector_type(4)));
typedef unsigned u32x4 __attribute__((ext_vector_type(4)));
constexpr int BM = 256, BK = 64, HALF = 128, HTB = HALF * BK * 2  , STAGE_BYTES = 8 * HTB, NXCD = 8, WGM = 8;

__host__ __device__ __forceinline__ int lds_byte(int r, int c) { const int st = (r >> 4) * 2 + (c >> 5), rr = r & 15, cc = c & 31, ob = rr * 64 + cc * 2; return st * 1024 + (ob ^ (((ob >> 9) & 1) << 5)); }
__host__ __device__ __forceinline__ void stage_rc(int b, int& R, int& C) { const int st = b / 1024, sb = b % 1024, swz = sb ^ (((sb >> 9) & 1) << 5); R = (st >> 1) * 16 + swz / 64; C = (st & 1) * 32 + (swz % 64) / 2; }
__host__ __device__ __forceinline__ int perm32(int rho) { const int n = rho >> 4, i = rho & 15; return 8 * (i >> 2) + 4 * n + (i & 3); }

struct Unit { int pm, pn; };
struct Gemm { const bf16_t* A; const bf16_t* Bt; int M, N, K; };

struct StaticOrder {
    int nM, nN, nwg, G, c;
    __host__ __device__ void init(int M, int N, int G_, int c_) { nM = M / BM; nN = N / BM; nwg = nM * nN; G = G_; c = c_; }
    __host__ __device__ bool next(int i, Unit& u) const {
        const long L = (long)i * G + c; if (L >= nwg) return false;
        int wgid = (int)L; { const int q = nwg / NXCD, r = nwg % NXCD, xcd = wgid % NXCD, off = wgid / NXCD; wgid = (xcd < r ? xcd * (q + 1) : r * (q + 1) + (xcd - r) * q) + off; }
        const int nig = WGM * nN, gid = wgid / nig, fm = gid * WGM, gsz = (nM - fm) < WGM ? (nM - fm) : WGM;
        u.pm = fm + ((wgid % nig) % gsz); u.pn = (wgid % nig) / gsz; return true;
    }
    __device__ __forceinline__ void a_ready(const Unit&) const {}
    __device__ __forceinline__ void done(const Unit&) const {}
};

typedef float f32x2_t __attribute__((ext_vector_type(2))); typedef __bf16 bf16x2_t __attribute__((ext_vector_type(2)));
__device__ __forceinline__ unsigned cvt_pk_bf16(float lo, float hi) { f32x2_t v = {lo, hi}; bf16x2_t b = __builtin_convertvector(v, bf16x2_t); return __builtin_bit_cast(unsigned, b); }
__device__ __forceinline__ float sigmoidf_(float x) { return __builtin_amdgcn_rcpf(1.0f + __expf(-x)); }
__device__ __forceinline__ float bflo(unsigned w) { return __uint_as_float(w << 16); }
__device__ __forceinline__ float bfhi(unsigned w) { return __uint_as_float(w & 0xffff0000u); }
#define PG8_TILE_BEGIN \
    _Pragma("unroll") for (int ai = 0; ai < 2; ++ai) _Pragma("unroll") for (int m = 0; m < 4; ++m) _Pragma("unroll") for (int bj = 0; bj < 2; ++bj) { \
        const int row = u.pm * BM + ai * HALF + wr * 64 + m * 16 + fr; const int ct = bj * HALF + wc * 32 + 8 * fq; f32x4 v0 = acc[ai][bj][m][0], v1 = acc[ai][bj][m][1];
#define PG8_TILE_END }
#define PG8_EPI_IDS int l_ = threadIdx.x; asm volatile("" : "+v"(l_)); const int fr = l_ & 15, fq = (l_ >> 4) & 3; const int wv_ = __builtin_amdgcn_readfirstlane(l_ >> 6), wr = wv_ >> 2, wc = wv_ & 3;

constexpr size_t UNIT_ELEMS = (size_t)65536 * 512;
constexpr float ATT_C2 = 0.125f * 1.4426950408889634f;
struct EpiProj {
    static constexpr bool PERM = true, AFTER_DRAIN = false;
    bf16_t* base;
    const float* hg_lb;
    template <int ACT> __device__ __forceinline__ void tile(const f32x4 (&acc)[2][2][4][2], const Unit& u, int wr, int wc, int fr, int fq, bf16_t* O, int ldc, int colt, int lbcol) const {
        float lb[2][8];
        if (ACT == 1) {
#pragma unroll
            for (int bj = 0; bj < 2; ++bj)
#pragma unroll
                for (int i = 0; i < 8; ++i) { const int c = lbcol + bj * HALF + wc * 32 + 8 * fq + i; lb[bj][i] = sigmoidf_(hg_lb[c] - hg_lb[512 + c]); }
        }
        PG8_TILE_BEGIN {
            float x[8] = {v0[0], v0[1], v0[2], v0[3], v1[0], v1[1], v1[2], v1[3]};
#pragma unroll
            for (int i = 0; i < 8; ++i) {
                if (ACT == 0) x[i] = x[i] * sigmoidf_(x[i]);
                else if (ACT == 1) { const float l = lb[bj][i]; x[i] = __logf(l + (1.0f - l) * sigmoidf_(x[i])); }
                else if (ACT == 3) x[i] = x[i] * ATT_C2;
                else if (ACT == 4) x[i] = sigmoidf_(x[i]);
            }
            u32x4 w; w.x = cvt_pk_bf16(x[0], x[1]); w.y = cvt_pk_bf16(x[2], x[3]); w.z = cvt_pk_bf16(x[4], x[5]); w.w = cvt_pk_bf16(x[6], x[7]);
            *(u32x4*)(O + (size_t)row * ldc + colt + ct) = w;
        } PG8_TILE_END
    }
    __device__ __forceinline__ void operator()(const f32x4 (&acc)[2][2][4][2], const Unit& u, int, int, int, int) const {
        PG8_EPI_IDS
        const int pn = u.pn;
        if (pn < 14) { const int g = pn >> 1; bf16_t* O = base + (size_t)g * UNIT_ELEMS; const int colt = (pn & 1) * 256;
            if (g == 0 || g == 3) tile<0>(acc, u, wr, wc, fr, fq, O, 512, colt, 0);
            else if (g == 1) tile<1>(acc, u, wr, wc, fr, fq, O, 512, colt, colt);
            else if (g == 4) tile<3>(acc, u, wr, wc, fr, fq, O, 512, colt, 0);
            else tile<2>(acc, u, wr, wc, fr, fq, O, 512, colt, 0);
        } else { const int g = (pn - 14) >> 2; bf16_t* O = base + (size_t)(7 + 2 * g) * UNIT_ELEMS; tile<PROBE_ACT>(acc, u, wr, wc, fr, fq, O, 1024, ((pn - 14) & 3) * 256, 0); }
    }
};
template <int ACT> struct EpiAct {
    static constexpr bool PERM = true, AFTER_DRAIN = false;
    bf16_t* O; int ldc;
    __device__ __forceinline__ void operator()(const f32x4 (&acc)[2][2][4][2], const Unit& u, int, int, int, int) const {
        PG8_EPI_IDS
        const int colt = u.pn * BM;
        PG8_TILE_BEGIN {
            if (ACT == 1) { v0 = __builtin_elementwise_max(v0, (f32x4){0.f, 0.f, 0.f, 0.f}); v1 = __builtin_elementwise_max(v1, (f32x4){0.f, 0.f, 0.f, 0.f}); v0 = v0 * v0; v1 = v1 * v1; }
            u32x4 w; w.x = cvt_pk_bf16(v0[0], v0[1]); w.y = cvt_pk_bf16(v0[2], v0[3]); w.z = cvt_pk_bf16(v1[0], v1[1]); w.w = cvt_pk_bf16(v1[2], v1[3]);
            *(u32x4*)(O + (size_t)row * ldc + colt + ct) = w;
        } PG8_TILE_END
    }
};
struct EpiGate {
    static constexpr bool PERM = true, AFTER_DRAIN = false;
    bf16_t* O; const bf16_t* gate; const bf16_t* add;
    __device__ __forceinline__ void operator()(const f32x4 (&acc)[2][2][4][2], const Unit& u, int, int, int, int) const {
        PG8_EPI_IDS
        const int colt = u.pn * BM;
        PG8_TILE_BEGIN {
            const size_t off = (size_t)row * 1024 + colt + ct;
            const u32x4 g = *(const u32x4*)(gate + off);
            float x[8] = {v0[0] * bflo(g.x), v0[1] * bfhi(g.x), v0[2] * bflo(g.y), v0[3] * bfhi(g.y), v1[0] * bflo(g.z), v1[1] * bfhi(g.z), v1[2] * bflo(g.w), v1[3] * bfhi(g.w)};
            if (add) { const u32x4 a = *(const u32x4*)(add + off);
                x[0] += bflo(a.x); x[1] += bfhi(a.x); x[2] += bflo(a.y); x[3] += bfhi(a.y); x[4] += bflo(a.z); x[5] += bfhi(a.z); x[6] += bflo(a.w); x[7] += bfhi(a.w); }
            u32x4 w; w.x = cvt_pk_bf16(x[0], x[1]); w.y = cvt_pk_bf16(x[2], x[3]); w.z = cvt_pk_bf16(x[4], x[5]); w.w = cvt_pk_bf16(x[6], x[7]);
            *(u32x4*)(O + off) = w;
        } PG8_TILE_END
    }
};
template <int MODE> struct EpiRes {
    static constexpr bool PERM = true, AFTER_DRAIN = false;
    float* O; const bf16_t* base; float alpha;
    __device__ __forceinline__ void operator()(const f32x4 (&acc)[2][2][4][2], const Unit& u, int, int, int, int) const {
        PG8_EPI_IDS
        const int colt = u.pn * BM;
        PG8_TILE_BEGIN {
            const size_t off = (size_t)row * 1024 + colt + ct;
            const u32x4 b = *(const u32x4*)(base + off);
            const f32x4 b0 = {bflo(b.x), bfhi(b.x), bflo(b.y), bfhi(b.y)}, b1 = {bflo(b.z), bfhi(b.z), bflo(b.w), bfhi(b.w)};
            f32x4 o0, o1;
            if (MODE == 0) { o0 = b0 * alpha + v0; o1 = b1 * alpha + v1; }
            else { const f32x4 p0 = *(const f32x4*)(O + off), p1 = *(const f32x4*)(O + off + 4);
                f32x4 s0, s1;
#pragma unroll
                for (int i = 0; i < 4; ++i) { s0[i] = sigmoidf_(v0[i]); s1[i] = sigmoidf_(v1[i]); }
                o0 = p0 + s0 * b0; o1 = p1 + s1 * b1; }
            *(f32x4*)(O + off) = o0; *(f32x4*)(O + off + 4) = o1;
        } PG8_TILE_END
    }
};
template <class Epi, class Sched, bool ALIGN_EPI = false, bool SP2 = false>
__device__ __forceinline__ void gemm_phase(PG8_LAS unsigned char* lds, const Gemm g, const Sched& S, const Epi& E) {
    int tid_ = threadIdx.x; asm volatile("" : "+v"(tid_)); const int tid = tid_, wid = __builtin_amdgcn_readfirstlane(tid >> 6), lane = tid & 63, wr = wid >> 2, wc = wid & 3, fr = lane & 15, fq = lane >> 4;
    const int K = g.K, nt = K / BK;
    unsigned voffA[2], voffB[2];
#pragma unroll
    for (int i = 0; i < 2; ++i) { int R, C; stage_rc(tid * 16 + i * 8192, R, C); const int Rb = Epi::PERM ? ((R & ~31) + perm32(R & 31)) : R;
        voffA[i] = (unsigned)(R * K + C) * 2u; voffB[i] = (unsigned)(Rb * K + C) * 2u; }
    const size_t kstep = (size_t)(BK * 2);
    const size_t hstep = (size_t)HALF * K * 2;
    const size_t tstep = 2 * hstep;
    const unsigned ldsw = (unsigned)wid * 1024u;
    const int aoff = lds_byte(wr * 64 + fr, fq * 8), boff = lds_byte(wc * 32 + fr, fq * 8);
#define PG8_SA(b, h) (((b) * 2 + (h)) * HTB)
#define PG8_SB(b, h) ((4 + (b) * 2 + (h)) * HTB)
#define PG8_STAGE(bufoff, gbase, voff) do { _Pragma("unroll") for (int _i = 0; _i < 2; ++_i) \
        __builtin_amdgcn_global_load_lds((const unsigned*)((const char*)(gbase) + (voff)[_i]), (PG8_LAS unsigned*)(lds + (bufoff) + ldsw + _i * 8192), 16, 0, PG8_AUX); } while (0)
#define PG8_LDA(dst, b, h) do { _Pragma("unroll") for (int m = 0; m < 4; ++m) _Pragma("unroll") for (int k = 0; k < 2; ++k) dst[m][k] = *(const PG8_LAS bf16x8*)(lds + PG8_SA(b, h) + aoff + m * 2048 + k * 1024); } while (0)
#define PG8_LDB(dst, b, h) do { _Pragma("unroll") for (int n = 0; n < 2; ++n) _Pragma("unroll") for (int k = 0; k < 2; ++k) dst[n][k] = *(const PG8_LAS bf16x8*)(lds + PG8_SB(b, h) + boff + n * 2048 + k * 1024); } while (0)
#define PG8_MMA(ai, bj, At, Bt) do { __builtin_amdgcn_s_setprio(1); _Pragma("unroll") for (int m = 0; m < 4; ++m) _Pragma("unroll") for (int n = 0; n < 2; ++n) _Pragma("unroll") for (int k = 0; k < 2; ++k) \
        acc[ai][bj][m][n] = __builtin_amdgcn_mfma_f32_16x16x32_bf16(Bt[n][k], At[m][k], acc[ai][bj][m][n], 0, 0, 0); __builtin_amdgcn_s_setprio(0); } while (0)
#ifdef PG8_STRICT
#define PG8_WAIT_V(n) asm volatile("s_waitcnt vmcnt(0)" ::: "memory")
#else
#define PG8_WAIT_V(n) asm volatile("s_waitcnt vmcnt(" #n ")" ::: "memory")
#endif
#define PG8_WAIT_L(n) asm volatile("s_waitcnt lgkmcnt(" #n ")" ::: "memory")
#define PG8_BAR __builtin_amdgcn_s_barrier()
#define PG8_SCHED __builtin_amdgcn_sched_barrier(0)
#ifdef PG8_SIMPLE
    {
        const unsigned lw = ldsw + (unsigned)lane * 16u;
#define PG8_GLD(dst, gbase, voff) do { _Pragma("unroll") for (int _i = 0; _i < 2; ++_i) dst[_i] = *(const u32x4*)((const char*)(gbase) + (voff)[_i]); } while (0)
#define PG8_LST(bufoff, src) do { _Pragma("unroll") for (int _i = 0; _i < 2; ++_i) *(PG8_LAS u32x4*)(lds + (bufoff) + lw + _i * 8192) = src[_i]; } while (0)
        Unit cur_;
        for (int ui_ = 0; S.next(ui_, cur_); ++ui_) {
            f32x4 acc[2][2][4][2];
#pragma unroll
            for (int a = 0; a < 2; ++a)
#pragma unroll
                for (int b = 0; b < 2; ++b)
#pragma unroll
                    for (int m = 0; m < 4; ++m)
#pragma unroll
                        for (int n = 0; n < 2; ++n) acc[a][b][m][n] = (f32x4){0.f, 0.f, 0.f, 0.f};
            bf16x8 At[4][2], B0[2][2], B1[2][2];
            u32x4 rb0[2], rb1[2], ra0[2], ra1[2];
            const char* cA = (const char*)g.A + (size_t)cur_.pm * tstep; const char* cB = (const char*)g.Bt + (size_t)cur_.pn * tstep;
            PG8_GLD(rb0, cB, voffB); PG8_GLD(rb1, cB + hstep, voffB); PG8_GLD(ra0, cA, voffA); PG8_GLD(ra1, cA + hstep, voffA);
            PG8_LST(PG8_SB(0, 0), rb0); PG8_LST(PG8_SB(0, 1), rb1); PG8_LST(PG8_SA(0, 0), ra0); PG8_LST(PG8_SA(0, 1), ra1);
            __syncthreads();
#define PG8_HALFSTEP(B_, NB_, tt) do { \
                const bool more_ = (tt) + 1 < nt; const char* a1 = cA + (size_t)((tt) + 1) * kstep; const char* b1 = cB + (size_t)((tt) + 1) * kstep; \
                if (more_) { PG8_GLD(rb0, b1, voffB); PG8_GLD(rb1, b1 + hstep, voffB); } \
                PG8_LDB(B0, B_, 0); PG8_LDB(B1, B_, 1); PG8_LDA(At, B_, 0); PG8_MMA(0, 0, At, B0); PG8_MMA(0, 1, At, B1); \
                if (more_) { PG8_LST(PG8_SB(NB_, 0), rb0); PG8_LST(PG8_SB(NB_, 1), rb1); PG8_GLD(rb0, a1, voffA); PG8_GLD(rb1, a1 + hstep, voffA); } \
                PG8_LDA(At, B_, 1); PG8_MMA(1, 0, At, B0); PG8_MMA(1, 1, At, B1); \
                if (more_) { PG8_LST(PG8_SA(NB_, 0), rb0); PG8_LST(PG8_SA(NB_, 1), rb1); } \
                __syncthreads(); } while (0)
            for (int t = 0; t < nt; t += 2) { PG8_HALFSTEP(0, 1, t); PG8_HALFSTEP(1, 0, t + 1); }
#undef PG8_HALFSTEP
            E(acc, cur_, wr, wc, fr, fq);
        }
#undef PG8_GLD
#undef PG8_LST
    }
#else
    Unit cur, nxt; int ui = 0;
    if (!S.next(0, cur)) return;
    f32x4 acc[2][2][4][2];
#pragma unroll
    for (int a = 0; a < 2; ++a)
#pragma unroll
        for (int b = 0; b < 2; ++b)
#pragma unroll
            for (int m = 0; m < 4; ++m)
#pragma unroll
                for (int n = 0; n < 2; ++n) acc[a][b][m][n] = (f32x4){0.f, 0.f, 0.f, 0.f};
    bf16x8 At[4][2], B0[2][2], B1[2][2];
    const char* cA = (const char*)g.A + (size_t)cur.pm * tstep; const char* cB = (const char*)g.Bt + (size_t)cur.pn * tstep;
    S.a_ready(cur);
    if constexpr (SP2) {
        PG8_STAGE(PG8_SB(0, 0), cB, voffB); PG8_STAGE(PG8_SB(0, 1), cB + hstep, voffB); PG8_STAGE(PG8_SA(0, 0), cA, voffA); PG8_STAGE(PG8_SA(0, 1), cA + hstep, voffA);
        if (wr == 1) PG8_BAR;
        PG8_WAIT_V(2); PG8_BAR;
        PG8_STAGE(PG8_SB(1, 0), cB + kstep, voffB); PG8_STAGE(PG8_SA(1, 0), cA + kstep, voffA); PG8_STAGE(PG8_SB(1, 1), cB + hstep + kstep, voffB);
        PG8_WAIT_V(6); PG8_BAR;
    } else {
        PG8_STAGE(PG8_SB(0, 0), cB, voffB); PG8_STAGE(PG8_SA(0, 0), cA, voffA); PG8_STAGE(PG8_SB(0, 1), cB + hstep, voffB); PG8_STAGE(PG8_SA(0, 1), cA + hstep, voffA);
        if (wr == 1) PG8_BAR;
        PG8_WAIT_V(4); PG8_BAR;
        PG8_STAGE(PG8_SB(1, 0), cB + kstep, voffB); PG8_STAGE(PG8_SA(1, 0), cA + kstep, voffA); PG8_STAGE(PG8_SB(1, 1), cB + hstep + kstep, voffB);
        PG8_WAIT_V(6); PG8_BAR;
    }
    for (;;) {
        const bool has_next = S.next(ui + 1, nxt);
        const char* nA = has_next ? (const char*)g.A + (size_t)nxt.pm * tstep : cA; const char* nB = has_next ? (const char*)g.Bt + (size_t)nxt.pn * tstep : cB;
        for (int t = 0; t < nt; t += 2) {
            const bool last = (t == nt - 2);
            const char* a1 = cA + (size_t)(t + 1) * kstep;
            const char* a2 = last ? nA : cA + (size_t)(t + 2) * kstep; const char* b2 = last ? nB : cB + (size_t)(t + 2) * kstep;
            const char* a3 = a2 + kstep; const char* b3 = b2 + kstep;
            if (last && has_next) S.a_ready(nxt);
            if constexpr (SP2) {
            PG8_LDB(B0, 0, 0); PG8_LDB(B1, 0, 1); PG8_SCHED; PG8_LDA(At, 0, 0); PG8_STAGE(PG8_SA(1, 1), a1 + hstep, voffA);
            PG8_WAIT_V(8); PG8_WAIT_L(0); PG8_BAR; PG8_MMA(0, 0, At, B0); PG8_MMA(0, 1, At, B1); PG8_BAR; PG8_SCHED;
            PG8_LDA(At, 0, 1); PG8_STAGE(PG8_SB(0, 0), b2, voffB); PG8_STAGE(PG8_SB(0, 1), b2 + hstep, voffB); PG8_STAGE(PG8_SA(0, 0), a2, voffA);
            PG8_WAIT_V(8); PG8_WAIT_L(0); PG8_BAR; PG8_MMA(1, 0, At, B0); PG8_MMA(1, 1, At, B1); PG8_BAR; PG8_SCHED;
            PG8_LDB(B0, 1, 0); PG8_LDB(B1, 1, 1); PG8_SCHED; PG8_LDA(At, 1, 0); PG8_STAGE(PG8_SA(0, 1), a2 + hstep, voffA);
            PG8_WAIT_V(8); PG8_WAIT_L(0); PG8_BAR; PG8_MMA(0, 0, At, B0); PG8_MMA(0, 1, At, B1); PG8_BAR; PG8_SCHED;
            PG8_LDA(At, 1, 1); PG8_STAGE(PG8_SB(1, 0), b3, voffB); PG8_STAGE(PG8_SB(1, 1), b3 + hstep, voffB); PG8_STAGE(PG8_SA(1, 0), a3, voffA);
            PG8_WAIT_V(8); PG8_WAIT_L(0); PG8_BAR; PG8_MMA(1, 0, At, B0); PG8_MMA(1, 1, At, B1); PG8_BAR; PG8_SCHED;
            } else {
            PG8_LDB(B0, 0, 0); PG8_SCHED; PG8_LDA(At, 0, 0); PG8_STAGE(PG8_SA(1, 1), a1 + hstep, voffA);
            PG8_WAIT_L(8); PG8_BAR; PG8_WAIT_L(0); PG8_MMA(0, 0, At, B0); PG8_BAR; PG8_SCHED;
            PG8_LDB(B1, 0, 1); PG8_STAGE(PG8_SB(0, 0), b2, voffB);
            PG8_BAR; PG8_WAIT_L(0); PG8_MMA(0, 1, At, B1); PG8_BAR;
            PG8_LDA(At, 0, 1); PG8_STAGE(PG8_SA(0, 0), a2, voffA);
            PG8_BAR; PG8_WAIT_L(0); PG8_MMA(1, 0, At, B0); PG8_BAR; PG8_SCHED;
            PG8_STAGE(PG8_SB(0, 1), b2 + hstep, voffB);
            PG8_WAIT_V(6); PG8_BAR; PG8_MMA(1, 1, At, B1); PG8_BAR;
            PG8_LDB(B0, 1, 0); PG8_SCHED; PG8_LDA(At, 1, 0); PG8_STAGE(PG8_SA(0, 1), a2 + hstep, voffA);
            PG8_WAIT_L(8); PG8_BAR; PG8_WAIT_L(0); PG8_MMA(0, 0, At, B0); PG8_BAR; PG8_SCHED;
            PG8_LDB(B1, 1, 1); PG8_STAGE(PG8_SB(1, 0), b3, voffB);
            PG8_BAR; PG8_WAIT_L(0); PG8_MMA(0, 1, At, B1); PG8_BAR;
            PG8_LDA(At, 1, 1); PG8_STAGE(PG8_SA(1, 0), a3, voffA);
            PG8_BAR; PG8_WAIT_L(0); PG8_MMA(1, 0, At, B0); PG8_BAR; PG8_SCHED;
            PG8_STAGE(PG8_SB(1, 1), b3 + hstep, voffB);
            PG8_WAIT_V(6); PG8_BAR; PG8_MMA(1, 1, At, B1); PG8_BAR;
            }
        }
        if constexpr (ALIGN_EPI) { if (wr == 0) PG8_BAR; }
        if constexpr (!Epi::AFTER_DRAIN) { E(acc, cur, wr, wc, fr, fq); S.done(cur); }
        if (!has_next) break;
#pragma unroll
        for (int a = 0; a < 2; ++a)
#pragma unroll
            for (int b = 0; b < 2; ++b)
#pragma unroll
                for (int m = 0; m < 4; ++m)
#pragma unroll
                    for (int n = 0; n < 2; ++n) acc[a][b][m][n] = (f32x4){0.f, 0.f, 0.f, 0.f};
        cur = nxt; cA = nA; cB = nB; ++ui;
        if constexpr (ALIGN_EPI) { if (wr == 1) PG8_BAR; }
    }
    PG8_WAIT_V(0);
    if constexpr (!ALIGN_EPI) { if (wr == 0) PG8_BAR; }
    PG8_BAR;
    if constexpr (Epi::AFTER_DRAIN) { E.fused(acc, cur, wr, wc, fr, fq, lds, wid, lane); S.done(cur); }
#endif
#undef PG8_SA
#undef PG8_SB
#undef PG8_STAGE
#undef PG8_LDA
#undef PG8_LDB
#undef PG8_MMA
#undef PG8_WAIT_V
#undef PG8_WAIT_L
#undef PG8_BAR
#undef PG8_SCHED
}
}
#include <hip/hip_bf16.h>
#include <cmath>
namespace attn_body {
using bf16=__hip_bfloat16;
using bf16x8=__attribute__((ext_vector_type(8)))short;
using s16x4=__attribute__((ext_vector_type(4)))short;
using f32x16=__attribute__((ext_vector_type(16)))float;
using u32x4=__attribute__((ext_vector_type(4)))unsigned;
using f32x4v=__attribute__((ext_vector_type(4)))float;
constexpr int BATCH=16,NHEAD=8,SEQ=4096,D=64,DM=NHEAD*D;
constexpr int NW=8,QBLK=32,QB=QBLK*NW,KVBLK=64,NQB=SEQ/QB;
constexpr int ATTN_PITCH=DM, ATTN_UNIT_ROWS=QB;
__device__ __forceinline__ int crow(int r,int hi){return (r&3)+8*(r>>2)+4*hi;}
#define SBAR() __builtin_amdgcn_sched_barrier(0)
__device__ __forceinline__ void cmask(f32x16&p0,f32x16&p1,int jb,int qrel,int hi){
  const float NEG=-INFINITY; int kb=64*jb+4*hi;
  #pragma unroll
  for(int r=0;r<16;++r){int kv=kb+(r&3)+8*(r>>2); if(kv>qrel)p0[r]=NEG; if(kv+32>qrel)p1[r]=NEG;}
}

constexpr int NSLOT=3, SLOTB=8192;
constexpr int LDS_K=0, LDS_V=NSLOT*SLOTB, LDS_WS=2*NSLOT*SLOTB, LDS_OST=LDS_WS+NW*64*4, LDS_CB=LDS_OST+NW*4096, LDS_BYTES=LDS_CB+SEQ*4;
constexpr float C2=0.125f*1.4426950408889634f;
__device__ __forceinline__ void glds16(const void*gsrc,unsigned lds_dst){unsigned keep;
  asm volatile("s_mov_b32 %0, m0\n\ts_mov_b32 m0, %2\n\ts_nop 0\n\tglobal_load_lds_dwordx4 %1, off\n\ts_mov_b32 m0, %0":"=&s"(keep):"v"(gsrc),"s"(lds_dst):"memory");}
__device__ __forceinline__ float max3f(float a,float b,float c){float r;asm("v_max3_f32 %0, %1, %2, %3":"=v"(r):"v"(a),"v"(b),"v"(c));return r;}
__device__ __forceinline__ float max2f(float a,float b){float r;asm("v_max_f32_e32 %0, %1, %2":"=v"(r):"v"(a),"v"(b));return r;}
__device__ __forceinline__ float fadd_s(float a,float b){float r;asm("v_add_f32_e32 %0, %1, %2":"=v"(r):"v"(a),"v"(b));return r;}
__device__ __forceinline__ float fsub_s(float a,float b){float r;asm("v_sub_f32_e32 %0, %1, %2":"=v"(r):"v"(a),"v"(b));return r;}
typedef float f32x2_t __attribute__((ext_vector_type(2))); typedef __bf16 bf16x2_t __attribute__((ext_vector_type(2)));
__device__ __forceinline__ unsigned cvtpk_s(float lo,float hi){f32x2_t v={lo,hi};bf16x2_t b=__builtin_convertvector(v,bf16x2_t);return __builtin_bit_cast(unsigned,b);}
#define WAIT_BAR(N) asm volatile("s_waitcnt vmcnt(" #N ") lgkmcnt(0)\n\ts_barrier":::"memory")

__device__ __forceinline__ void qkt(f32x16&p0,f32x16&p1,const char*Kslot,const bf16x8*qr,const f32x16&negm,int r32,int hi){
  const char*kb=Kslot+hi*1024+r32*16;
  #pragma unroll
  for(int d0=0;d0<4;++d0){
    const bf16x8 b0=*reinterpret_cast<const bf16x8*>(kb+d0*2048);
    const bf16x8 b1=*reinterpret_cast<const bf16x8*>(kb+d0*2048+512);
    if(d0==0){p0=__builtin_amdgcn_mfma_f32_32x32x16_bf16(b0,qr[0],negm,0,0,0);p1=__builtin_amdgcn_mfma_f32_32x32x16_bf16(b1,qr[0],negm,0,0,0);}
    else{p0=__builtin_amdgcn_mfma_f32_32x32x16_bf16(b0,qr[d0],p0,0,0,0);p1=__builtin_amdgcn_mfma_f32_32x32x16_bf16(b1,qr[d0],p1,0,0,0);}}
}
typedef __attribute__((address_space(3))) const char* lds_cptr;
typedef short v4i16_t __attribute__((ext_vector_type(4)));
__device__ __forceinline__ void kload8(bf16x8*kf,lds_cptr kp){
  kf[0]=*(const __attribute__((address_space(3))) bf16x8*)(kp);      kf[1]=*(const __attribute__((address_space(3))) bf16x8*)(kp+512);
  kf[2]=*(const __attribute__((address_space(3))) bf16x8*)(kp+2048); kf[3]=*(const __attribute__((address_space(3))) bf16x8*)(kp+2560);
  kf[4]=*(const __attribute__((address_space(3))) bf16x8*)(kp+4096); kf[5]=*(const __attribute__((address_space(3))) bf16x8*)(kp+4608);
  kf[6]=*(const __attribute__((address_space(3))) bf16x8*)(kp+6144); kf[7]=*(const __attribute__((address_space(3))) bf16x8*)(kp+6656);
}
__device__ __forceinline__ void kload2(bf16x8*kf,lds_cptr kp,int j){ kf[2*j]=*(const __attribute__((address_space(3))) bf16x8*)(kp+j*2048); kf[2*j+1]=*(const __attribute__((address_space(3))) bf16x8*)(kp+j*2048+512); }
__device__ __forceinline__ s16x4 vtr(lds_cptr p){ return __builtin_bit_cast(s16x4,__builtin_amdgcn_ds_read_tr16_b64_v4i16((__attribute__((address_space(3))) v4i16_t*)p)); }
__device__ __forceinline__ float rowmax(const f32x16&p0,const f32x16&p1){
  float a=max3f(p0[0],p0[1],p1[0]),b=max3f(p0[2],p0[3],p1[1]);a=max3f(a,p1[2],p1[3]);
  #pragma unroll
  for(int r=4;r<16;r+=4){a=max3f(a,p0[r],p0[r+1]);b=max3f(b,p0[r+2],p0[r+3]);a=max3f(a,p1[r],p1[r+1]);b=max3f(b,p1[r+2],p1[r+3]);}
  const float m=max2f(a,b);
  auto rr=__builtin_amdgcn_permlane32_swap(__float_as_uint(m),__float_as_uint(m),false,false);
  return max2f(__uint_as_float(rr[0]),__uint_as_float(rr[1]));
}
__device__ __forceinline__ void pv(f32x16*o,int vb,bf16x8 pa0,bf16x8 pa1,bf16x8 pa2,bf16x8 pa3){
  #pragma unroll
  for(int d0=0;d0<2;++d0){s16x4 lo[4],hi[4];
    #pragma unroll
    for(int ks=0;ks<4;++ks){
      asm volatile("ds_read_b64_tr_b16 %0,%1 offset:%c2":"=&v"(lo[ks]):"v"(vb),"i"(d0*4096+ks*1024):"memory");
      asm volatile("ds_read_b64_tr_b16 %0,%1 offset:%c2":"=&v"(hi[ks]):"v"(vb),"i"(d0*4096+ks*1024+512):"memory");}
    asm volatile("s_waitcnt lgkmcnt(0)":::"memory");SBAR();
    #define PK(k) (bf16x8){lo[k][0],lo[k][1],lo[k][2],lo[k][3],hi[k][0],hi[k][1],hi[k][2],hi[k][3]}
    o[d0]=__builtin_amdgcn_mfma_f32_32x32x16_bf16(pa0,PK(0),o[d0],0,0,0);
    o[d0]=__builtin_amdgcn_mfma_f32_32x32x16_bf16(pa1,PK(1),o[d0],0,0,0);
    o[d0]=__builtin_amdgcn_mfma_f32_32x32x16_bf16(pa2,PK(2),o[d0],0,0,0);
    o[d0]=__builtin_amdgcn_mfma_f32_32x32x16_bf16(pa3,PK(3),o[d0],0,0,0);
    #undef PK
  }
}

#ifndef ATTN_STORE16
#define ATTN_STORE16(p,v) (*(u32x4*)(p)=(v))
#endif
template<int THRL> __device__ __forceinline__ void attn_unit(int b,int h,int qb,const bf16*Q,const bf16*__restrict__ K,const bf16*__restrict__ V,bf16*O,const float*__restrict__ Cbh,char*shm){
  int tid_=threadIdx.x; asm volatile("":"+v"(tid_));
  const int tid=tid_,lane=tid&63,r32=lane&31,hi=lane>>5; const int wid=__builtin_amdgcn_readfirstlane(tid>>6);
  const long rowbase=(long)b*SEQ; const int q0=qb*QB;
  const bf16*Qw=Q+(rowbase+q0+wid*QBLK)*DM+h*D;
  const bf16*Kh=K+rowbase*DM+h*D,*Vh=V+rowbase*DM+h*D;
  const unsigned lds0=(unsigned)(uintptr_t)shm;
  float*wsf=(float*)(shm+LDS_WS)+wid*64;
  const bf16*ksrc=Kh+(long)lane*DM+wid*8;
  const bf16*vsrc=Vh+(long)(16*(wid&3)+(lane>>2))*DM+(wid>>2)*32+(lane&3)*8;
  const unsigned kdst=lds0+LDS_K+wid*1024, vdst=lds0+LDS_V+wid*1024;
  #define DMA_K(t,slot) glds16(ksrc+(long)(t)*KVBLK*DM,(unsigned)__builtin_amdgcn_readfirstlane(kdst+(slot)))
  #define DMA_V(t,slot) glds16(vsrc+(long)(t)*KVBLK*DM,(unsigned)__builtin_amdgcn_readfirstlane(vdst+(slot)))
  const int vb0=(int)(lds0+LDS_V)+((lane>>4)&1)*32+(lane&3)*8+(4*hi+((lane&15)>>2))*64;
  const char*Kbase=shm+LDS_K; bf16x8 kf[8];
  const lds_cptr shm3=(lds_cptr)shm; const lds_cptr kp0=shm3+LDS_K+hi*1024+r32*16; const lds_cptr vp0=shm3+LDS_V+((lane>>4)&1)*32+(lane&3)*8+(4*hi+((lane&15)>>2))*64;
  const int NT=(q0+QB)/KVBLK;
  typedef __attribute__((address_space(3))) f32x4v* cb_wptr; typedef __attribute__((address_space(3))) const f32x4v* cb_lptr;
  float cq2;
  { const float c2ref=Cbh[q0]; const int nk4=(q0+QB)>>2; cb_wptr cw=(cb_wptr)((__attribute__((address_space(3))) char*)shm+LDS_CB);
    for(int i=tid;i<nk4;i+=NW*64){ f32x4v v=*(const f32x4v*)(Cbh+4*i); v=v-c2ref; cw[i]=v; }
    cq2=Cbh[q0+wid*QBLK+r32]-c2ref;
    asm volatile("s_waitcnt vmcnt(0) lgkmcnt(0)":::"memory"); }
  DMA_K(0,0);DMA_V(0,0);DMA_K(1,SLOTB);
  bf16x8 qr[4];
  #pragma unroll
  for(int d0=0;d0<4;++d0)qr[d0]=*reinterpret_cast<const bf16x8*>(&Qw[(long)r32*DM+d0*16+hi*8]);
  float mhat=0.f,l_reg=0.f;f32x16 o[2];o[0]=f32x16{};o[1]=f32x16{};const f32x16 zz16=f32x16{}; float mq=-cq2;
  const int qrel=wid*QBLK+r32;
  #define CMASK(P0,P1,t) do{int jb_=(t)-(NT-4); if(jb_>=0)cmask(P0,P1,jb_,qrel,hi);}while(0)
  const cb_lptr cb0=(cb_lptr)((__attribute__((address_space(3))) const char*)shm+LDS_CB+hi*16);
  #define BIAS(P0,P1,t) do{ const cb_lptr cp_=cb0+(t)*16; \
    _Pragma("unroll") for(int h_=0;h_<2;++h_){ \
    _Pragma("unroll") for(int j_=2*h_;j_<2*h_+2;++j_){ const f32x4v a_=cp_[2*j_]+mq, b_=cp_[8+2*j_]+mq; \
      P0[4*j_]-=a_[0];P0[4*j_+1]-=a_[1];P0[4*j_+2]-=a_[2];P0[4*j_+3]-=a_[3]; P1[4*j_]-=b_[0];P1[4*j_+1]-=b_[1];P1[4*j_+2]-=b_[2];P1[4*j_+3]-=b_[3]; } SBAR(); } }while(0)
  bool resc=false;
  #define START(P0,P1) do{ const float rm=__builtin_fmaxf(rowmax(P0,P1),0.f); resc=false; \
    { const float dl=rm; mhat=fadd_s(mhat,dl); \
      _Pragma("unroll") for(int r=0;r<16;++r){P0[r]=fsub_s(P0[r],dl);P1[r]=fsub_s(P1[r],dl);} \
      mq=mhat-cq2; } \
    _Pragma("unroll") for(int r=0;r<16;++r)P0[r]=__builtin_amdgcn_exp2f(P0[r]); }while(0)
  #define RESC() do{ if(resc){ asm volatile("s_waitcnt lgkmcnt(0)":::"memory"); \
      _Pragma("unroll") for(int d_=0;d_<2;++d_) _Pragma("unroll") for(int r=0;r<16;++r)o[d_][r]*=wsf[crow(r,hi)]; } }while(0)
  f32x16 pA0,pA1,pB0,pB1;
  int sl_prev=0,sl_cur=0,sl_next=SLOTB;
  #define ROT() do{sl_prev=sl_cur;sl_cur=sl_next;sl_next=(sl_next==(NSLOT-1)*SLOTB)?0:sl_next+SLOTB;}while(0)
  DMA_K(2,2*SLOTB);
  WAIT_BAR(3);
  qkt(pA0,pA1,Kbase,qr,zz16,r32,hi);asm volatile("s_nop 15\n\ts_nop 7":"+v"(pA0),"+v"(pA1));BIAS(pA0,pA1,0);CMASK(pA0,pA1,0);
  START(pA0,pA1);
  _Pragma("unroll") for(int r=0;r<16;++r)pA1[r]=__builtin_amdgcn_exp2f(pA1[r]);
  WAIT_BAR(0);
  DMA_K(3,0);DMA_V(1,SLOTB);
  ROT();
  kload8(kf,kp0+sl_cur);
  WAIT_BAR(2);
  s16x4 vlo[8],vhi[8]; u32x4 pw0,pw1,pw2,pw3;
  #define PKW(P,B) cvtpk_s(P[B],P[B+1])
  #define PAF(k) __builtin_bit_cast(bf16x8,pw##k)
  #define VFR(i) (bf16x8){vlo[i][0],vlo[i][1],vlo[i][2],vlo[i][3],vhi[i][0],vhi[i][1],vhi[i][2],vhi[i][3]}
  #define PIN(x) asm volatile("":"+v"(x))
  #define MX3(a,b,c) __builtin_fmaxf(__builtin_fmaxf((a),(b)),(c))
  #define GAPA(MF,A0,A1,A2,A3,W0,W1,PW) do{ MF; sacc+=A0; sacc+=A1; sacc+=A2; sacc+=A3; PIN(sacc); W0; W1; PIN(PW); SBAR(); }while(0)
  #define EX(v) __builtin_amdgcn_exp2f(v)
  #define GAPB(MF,X,B) do{ MF; X[B]=EX(X[B]); X[B+1]=EX(X[B+1]); X[B+2]=EX(X[B+2]); X[B+3]=EX(X[B+3]); PIN(X); SBAR(); }while(0)
  #define VRD(i) do{ vlo[i]=vtr(vp_+(((i)>>2)*4096+((i)&3)*1024)); vhi[i]=vtr(vp_+(((i)>>2)*4096+((i)&3)*1024+512)); }while(0)
  #define KRD(G,j) do{ if(G){ kload2(kf,kp0+sl_next,j); SBAR(); } }while(0)
  #define STEP(C0,C1,P0,P1,t,GK,GV,GL) do{ SBAR(); \
    const lds_cptr vp_=vp0+sl_prev; \
    VRD(0); SBAR(); float sacc=(P0[0]+P0[1]); \
    GAPA(C0=__builtin_amdgcn_mfma_f32_32x32x16_bf16(kf[0],qr[0],zz16,0,0,0), P0[2],P0[3],P0[4],P0[5],     pw0[0]=PKW(P0,0), pw0[1]=PKW(P0,2), pw0); \
    VRD(4); SBAR(); GAPA(C1=__builtin_amdgcn_mfma_f32_32x32x16_bf16(kf[1],qr[0],zz16,0,0,0), P0[6],P0[7],P0[8],P0[9],     pw0[2]=PKW(P0,4), pw0[3]=PKW(P0,6), pw0); \
    VRD(1); SBAR(); GAPA(C0=__builtin_amdgcn_mfma_f32_32x32x16_bf16(kf[2],qr[1],C0,0,0,0),   P0[10],P0[11],P0[12],P0[13], pw1[0]=PKW(P0,8), pw1[1]=PKW(P0,10), pw1); \
    VRD(5); SBAR(); GAPA(C1=__builtin_amdgcn_mfma_f32_32x32x16_bf16(kf[3],qr[1],C1,0,0,0),   P0[14],P0[15],P1[0],P1[1],   pw1[2]=PKW(P0,12),pw1[3]=PKW(P0,14), pw1); \
    VRD(2); SBAR(); GAPA(C0=__builtin_amdgcn_mfma_f32_32x32x16_bf16(kf[4],qr[2],C0,0,0,0),   P1[2],P1[3],P1[4],P1[5],     pw2[0]=PKW(P1,0), pw2[1]=PKW(P1,2), pw2); \
    VRD(6); SBAR(); GAPA(C1=__builtin_amdgcn_mfma_f32_32x32x16_bf16(kf[5],qr[2],C1,0,0,0),   P1[6],P1[7],P1[8],P1[9],     pw2[2]=PKW(P1,4), pw2[3]=PKW(P1,6), pw2); \
    VRD(3); SBAR(); GAPA(C0=__builtin_amdgcn_mfma_f32_32x32x16_bf16(kf[6],qr[3],C0,0,0,0),   P1[10],P1[11],P1[12],P1[13], pw3[0]=PKW(P1,8), pw3[1]=PKW(P1,10), pw3); \
    VRD(7); SBAR(); GAPA(C1=__builtin_amdgcn_mfma_f32_32x32x16_bf16(kf[7],qr[3],C1,0,0,0),   P1[14],P1[15],0.f,0.f,       pw3[2]=PKW(P1,12),pw3[3]=PKW(P1,14), pw3); \
    l_reg+=sacc; \
    if(GK){DMA_K((t)+3,sl_cur);} if(GV){DMA_V((t)+1,sl_next);} \
    BIAS(C0,C1,t); CMASK(C0,C1,t); \
    { float a=MX3(C0[0],C0[1],C1[0]),b=MX3(C0[2],C0[3],C1[1]); a=MX3(a,C1[2],C1[3]); \
      _Pragma("unroll") for(int r=4;r<16;r+=4){a=MX3(a,C0[r],C0[r+1]);b=MX3(b,C0[r+2],C0[r+3]);a=MX3(a,C1[r],C1[r+1]);b=MX3(b,C1[r+2],C1[r+3]);} \
      float rm=__builtin_fmaxf(a,b); { auto rr=__builtin_amdgcn_permlane32_swap(__float_as_uint(rm),__float_as_uint(rm),false,false); rm=__builtin_fmaxf(__uint_as_float(rr[0]),__uint_as_float(rr[1])); } \
      resc=false; \
      if(__builtin_expect(__any(rm>(float)THRL),0)){ const float dl=__builtin_fmaxf(rm,0.f); mhat+=dl; \
        _Pragma("unroll") for(int r=0;r<16;++r){C0[r]-=dl;C1[r]-=dl;} \
        mq=mhat-cq2; \
        const float f=__builtin_amdgcn_exp2f(-dl); l_reg*=f; if(hi==0)wsf[r32]=f; resc=true; } } \
    SBAR(); \
    GAPB(o[0]=__builtin_amdgcn_mfma_f32_32x32x16_bf16(PAF(0),VFR(0),o[0],0,0,0), C0,0); \
    GAPB(o[1]=__builtin_amdgcn_mfma_f32_32x32x16_bf16(PAF(0),VFR(4),o[1],0,0,0), C0,4); \
    KRD(GL,0); GAPB(o[0]=__builtin_amdgcn_mfma_f32_32x32x16_bf16(PAF(1),VFR(1),o[0],0,0,0), C0,8); \
    KRD(GL,1); GAPB(o[1]=__builtin_amdgcn_mfma_f32_32x32x16_bf16(PAF(1),VFR(5),o[1],0,0,0), C0,12); \
    KRD(GL,2); GAPB(o[0]=__builtin_amdgcn_mfma_f32_32x32x16_bf16(PAF(2),VFR(2),o[0],0,0,0), C1,0); \
    KRD(GL,3); GAPB(o[1]=__builtin_amdgcn_mfma_f32_32x32x16_bf16(PAF(2),VFR(6),o[1],0,0,0), C1,4); \
    GAPB(o[0]=__builtin_amdgcn_mfma_f32_32x32x16_bf16(PAF(3),VFR(3),o[0],0,0,0), C1,8); \
    GAPB(o[1]=__builtin_amdgcn_mfma_f32_32x32x16_bf16(PAF(3),VFR(7),o[1],0,0,0), C1,12); \
    }while(0)
  int t=1;
  #undef CMASK
  #define CMASK(P0,P1,t) do{}while(0)
  for(;t+5<NT;t+=2){
    STEP(pB0,pB1,pA0,pA1,t,true,true,true);     WAIT_BAR(2); RESC(); ROT();
    STEP(pA0,pA1,pB0,pB1,t+1,true,true,true);   WAIT_BAR(2); RESC(); ROT();
  }
  #undef CMASK
  #define CMASK(P0,P1,t) do{int jb_=(t)-(NT-4); if(jb_>=0)cmask(P0,P1,jb_,qrel,hi);}while(0)
  #define ENDW(tt) do{ if((tt)+3<NT){WAIT_BAR(2);} else if((tt)+2<NT){WAIT_BAR(1);} else {WAIT_BAR(0);} }while(0)
  for(;t+1<NT;t+=2){
    STEP(pB0,pB1,pA0,pA1,t,(t+3<NT),(t+1<NT),(t+1<NT));       ENDW(t);   RESC(); ROT();
    STEP(pA0,pA1,pB0,pB1,t+1,(t+4<NT),(t+2<NT),(t+2<NT));     ENDW(t+1); RESC(); ROT();
  }
  STEP(pB0,pB1,pA0,pA1,NT-1,false,false,false); RESC();
  { float sacc=pB0[0]+pB0[1]; _Pragma("unroll") for(int r=2;r<16;++r)sacc+=pB0[r]; _Pragma("unroll") for(int r=0;r<16;++r)sacc+=pB1[r]; l_reg+=sacc;
    pw0=(u32x4){PKW(pB0,0),PKW(pB0,2),PKW(pB0,4),PKW(pB0,6)};pw1=(u32x4){PKW(pB0,8),PKW(pB0,10),PKW(pB0,12),PKW(pB0,14)};pw2=(u32x4){PKW(pB1,0),PKW(pB1,2),PKW(pB1,4),PKW(pB1,6)};pw3=(u32x4){PKW(pB1,8),PKW(pB1,10),PKW(pB1,12),PKW(pB1,14)};
    SBAR(); pv(o,vb0+sl_cur,PAF(0),PAF(1),PAF(2),PAF(3)); }
  #undef PKW
  #undef PAF
  #undef VFR
  #undef PIN
  #undef MX3
  #undef GAPA
  #undef GAPB
  #undef EX
  #undef VRD
  #undef KRD
  #undef STEP
  #undef ENDW
  {auto rr=__builtin_amdgcn_permlane32_swap(__float_as_uint(l_reg),__float_as_uint(l_reg),false,false);l_reg=__uint_as_float(rr[0])+__uint_as_float(rr[1]);}
  if(hi==0)wsf[32+r32]=l_reg;asm volatile("s_waitcnt lgkmcnt(0)":::"memory");
  float rli[16];
  #pragma unroll
  for(int r=0;r<16;++r)rli[r]=__builtin_amdgcn_rcpf(wsf[32+crow(r,hi)]);
  bf16*Ow=O+(rowbase+q0+wid*QBLK)*DM+h*D;
  { bf16*stg=(bf16*)(shm+LDS_OST)+wid*2048;
    #pragma unroll
    for(int r=0;r<16;++r){const int orow=crow(r,hi);
      #pragma unroll
      for(int d0=0;d0<2;++d0)stg[orow*64+d0*32+r32]=__float2bfloat16(o[d0][r]*rli[r]);}
    asm volatile("s_waitcnt lgkmcnt(0)":::"memory");
    #pragma unroll
    for(int i=0;i<4;++i){const int row=i*8+(lane>>3),ch=lane&7; const u32x4 v=*(const u32x4*)(stg+row*64+ch*8); ATTN_STORE16(Ow+(long)row*DM+ch*8,v);} }
  asm volatile("s_waitcnt lgkmcnt(0)\n\ts_barrier":::"memory");
  #undef BIAS
  #undef DMA_K
  #undef DMA_V
  #undef CMASK
  #undef START
  #undef RESC
  #undef ROT
}
constexpr int ATTN_LDS_BYTES=LDS_BYTES;
#undef SBAR
#undef WAIT_BAR
}
#define LAS __attribute__((address_space(3)))
typedef unsigned short bf16;
typedef float f32x4 __attribute__((ext_vector_type(4)));
typedef unsigned v4u __attribute__((ext_vector_type(4)));
typedef unsigned v2u __attribute__((ext_vector_type(2)));
typedef short bf16x8 __attribute__((ext_vector_type(8)));
typedef short bf16x4 __attribute__((ext_vector_type(4)));
constexpr int NWAVES = 8, NTHR = 512;
constexpr int BATCH = 16, SEQ = 4096, T = BATCH * SEQ, D = 1024, FF = 4096, PLE = 256, NIN = 5640, NPROJ = 5632, HGW = 512, NHF = 8;
constexpr float LN_EPS = 1e-5f, RMS_EPS = 1e-6f, ALPHA = 1.189207115002721f, LOG2E = 1.4426950408889634f;
constexpr size_t MiB = 1u << 20, UNIT = 64 * MiB;
constexpr size_t WS_CTL = 0;
constexpr size_t WS_LF = 1 * MiB;
constexpr size_t WS_C2 = 3 * MiB;
constexpr size_t WS_WIN = 6 * MiB;
constexpr size_t WS_WA = 17 * MiB, WS_WB = 18 * MiB, WS_WO = 19 * MiB, WS_WPG = 21 * MiB, WS_WP = 23 * MiB;
constexpr size_t WS_WFF1 = 24 * MiB, WS_WFF2 = 32 * MiB;
constexpr size_t WS_H = 1 * UNIT;
constexpr size_t WS_PROJ = 3 * UNIT;
constexpr size_t WS_YA = 14 * UNIT;
constexpr size_t WS_PB = 15 * UNIT;
constexpr size_t WS_TMP = 3 * UNIT, WS_MERGED = 5 * UNIT;
constexpr size_t WS_FF1 = 3 * UNIT;
constexpr size_t WS_PE = 11 * UNIT;
constexpr size_t WS_END = 16 * UNIT;
constexpr int RING_BYTES = 131072, MISC_OFF = RING_BYTES, LDS_BYTES = 147456;

struct Args { const float* in[19]; float* out; unsigned char* ws; };

__device__ __forceinline__ unsigned f2bf(float f) { unsigned u = __builtin_bit_cast(unsigned, f); return (u + 0x7fffu + ((u >> 16) & 1u)) >> 16; }
__device__ __forceinline__ unsigned pk2(float lo, float hi) { return f2bf(lo) | (f2bf(hi) << 16); }
__device__ __forceinline__ float bf2f(unsigned short h) { return __uint_as_float((unsigned)h << 16); }
__device__ __forceinline__ float wave_sum(float v) {
#pragma unroll
    for (int o = 1; o < 64; o <<= 1) v += __shfl_xor(v, o);
    return v;
}
__device__ __forceinline__ void p0_transpose_item(const float* W, int K, int ldw, int nblk, bf16* WT, LAS float* scr, int item, int lane, int split, int shift) {
    const int kb = item / nblk, nb = item % nblk, k0 = 64 * kb, n0 = 32 * nb; const int s0 = n0 + (n0 >= split ? shift : 0);
#pragma unroll 8
    for (int i = 0; i < 32; ++i) { const int kk = 2 * i + (lane >> 5); scr[kk * 33 + (lane & 31)] = W[(size_t)(k0 + kk) * ldw + s0 + (lane & 31)]; }
    asm volatile("s_waitcnt lgkmcnt(0)" ::: "memory");
    const int c = lane & 7;
#pragma unroll
    for (int j = 0; j < 4; ++j) { const int n = (lane >> 3) + 8 * j; const LAS float* s = scr + (8 * c) * 33 + n;
        v4u o; o.x = pk2(s[0 * 33], s[1 * 33]); o.y = pk2(s[2 * 33], s[3 * 33]); o.z = pk2(s[4 * 33], s[5 * 33]); o.w = pk2(s[6 * 33], s[7 * 33]);
        *(v4u*)(WT + (size_t)(n0 + n) * K + k0 + 8 * c) = o; }
    asm volatile("s_waitcnt lgkmcnt(0)" ::: "memory");
}

__device__ __forceinline__ void p0_prologue(const Args& a, LAS unsigned char* lds, int G) {
    int tid_ = threadIdx.x; asm volatile("" : "+v"(tid_)); const int tid = tid_, lane = tid & 63, wave = __builtin_amdgcn_readfirstlane(tid >> 6);
    unsigned char* ws = a.ws;
    if (blockIdx.x == 0 && tid < 64) ((unsigned*)(ws + WS_CTL))[tid] = 0u;
    const int gw = blockIdx.x * NWAVES + wave, NGW = G * NWAVES;
    const float* w_in = a.in[4];
    {
        LAS float* scr = (LAS float*)(lds + wave * 8704);
        constexpr int I_IN = (D / 64) * (NPROJ / 32), I_A = (HGW / 64) * (D / 32), I_O = (D / 64) * (D / 32), I_F1 = (D / 64) * (FF / 32), I_F2 = (FF / 64) * (D / 32), I_P = (PLE / 64) * (D / 32);
        constexpr int NITEMS = I_IN + 2 * I_A + 2 * I_O + I_F1 + I_F2 + I_P;
        for (int it = gw; it < NITEMS; it += NGW) {
            int r = it;
            if (r < I_IN) { p0_transpose_item(w_in, D, NIN, NPROJ / 32, (bf16*)(ws + WS_WIN), scr, r, lane, 3584, 8); continue; } r -= I_IN;
            if (r < I_A) { p0_transpose_item(a.in[8], HGW, D, D / 32, (bf16*)(ws + WS_WA), scr, r, lane, 1 << 30, 0); continue; } r -= I_A;
            if (r < I_A) { p0_transpose_item(a.in[9], HGW, D, D / 32, (bf16*)(ws + WS_WB), scr, r, lane, 1 << 30, 0); continue; } r -= I_A;
            if (r < I_O) { p0_transpose_item(a.in[10], D, D, D / 32, (bf16*)(ws + WS_WO), scr, r, lane, 1 << 30, 0); continue; } r -= I_O;
            if (r < I_O) { p0_transpose_item(a.in[15], D, D, D / 32, (bf16*)(ws + WS_WPG), scr, r, lane, 1 << 30, 0); continue; } r -= I_O;
            if (r < I_F1) { p0_transpose_item(a.in[13], D, FF, FF / 32, (bf16*)(ws + WS_WFF1), scr, r, lane, 1 << 30, 0); continue; } r -= I_F1;
            if (r < I_F2) { p0_transpose_item(a.in[14], FF, D, D / 32, (bf16*)(ws + WS_WFF2), scr, r, lane, 1 << 30, 0); continue; } r -= I_F2;
            p0_transpose_item(a.in[16], PLE, D, D / 32, (bf16*)(ws + WS_WP), scr, r, lane, 1 << 30, 0);
        }
    }
    __syncthreads();
    LAS float* wf = (LAS float*)lds;
    for (int i = tid; i < D * 8; i += NTHR) wf[i] = w_in[(size_t)(i >> 3) * NIN + 3584 + (i & 7)];
    __syncthreads();
    { const float* p = a.in[1]; bf16* pb = (bf16*)(ws + WS_PB);
      for (size_t i = (size_t)blockIdx.x * NTHR + tid; i < (size_t)T * PLE / 8; i += (size_t)G * NTHR) {
          const f32x4 x0 = *(const f32x4*)(p + 8 * i), x1 = *(const f32x4*)(p + 8 * i + 4);
          v4u o; o.x = pk2(x0.x, x0.y); o.y = pk2(x0.z, x0.w); o.z = pk2(x1.x, x1.y); o.w = pk2(x1.z, x1.w); *(v4u*)(pb + 8 * i) = o; } }
    const float* x = a.in[0]; const float* g0 = a.in[2]; const float* b0 = a.in[3]; const float* fb = a.in[7];
    bf16* H = (bf16*)(ws + WS_H); float* LF = (float*)(ws + WS_LF);
    f32x4 gv[4], bv[4];
#pragma unroll
    for (int j = 0; j < 4; ++j) { gv[j] = *(const f32x4*)(g0 + 256 * j + 4 * lane); bv[j] = *(const f32x4*)(b0 + 256 * j + 4 * lane); }
    for (int m = gw; m < T; m += NGW) {
        const f32x4* xr = (const f32x4*)(x + (size_t)m * D) + lane;
        f32x4 v[4]; float s = 0.f;
#pragma unroll
        for (int j = 0; j < 4; ++j) { v[j] = xr[64 * j]; s += (v[j].x + v[j].y) + (v[j].z + v[j].w); }
        const float mean = wave_sum(s) * (1.f / D); float s2 = 0.f;
#pragma unroll
        for (int j = 0; j < 4; ++j) { v[j] = v[j] - mean; s2 += (v[j].x * v[j].x + v[j].y * v[j].y) + (v[j].z * v[j].z + v[j].w * v[j].w); }
        const float rstd = 1.f / sqrtf(wave_sum(s2) * (1.f / D) + LN_EPS);
        unsigned long long* o8 = (unsigned long long*)(H + (size_t)m * D) + lane;
        float fa[8] = {0.f, 0.f, 0.f, 0.f, 0.f, 0.f, 0.f, 0.f};
#pragma unroll
        for (int j = 0; j < 4; ++j) {
            v[j] = v[j] * rstd * gv[j] + bv[j];
            o8[64 * j] = (unsigned long long)pk2(v[j].x, v[j].y) | ((unsigned long long)pk2(v[j].z, v[j].w) << 32);
#pragma unroll
            for (int e = 0; e < 4; ++e) { const LAS f32x4* wp = (const LAS f32x4*)(wf + (256 * j + 4 * lane + e) * 8); const f32x4 w0 = wp[0], w1 = wp[1]; const float hv = v[j][e];
                fa[0] += hv * w0.x; fa[1] += hv * w0.y; fa[2] += hv * w0.z; fa[3] += hv * w0.w; fa[4] += hv * w1.x; fa[5] += hv * w1.y; fa[6] += hv * w1.z; fa[7] += hv * w1.w; }
        }
        float mine = 0.f;
#pragma unroll
        for (int e = 0; e < 8; ++e) { const float t = wave_sum(fa[e]); if (lane == e) mine = t; }
        if (lane < 8) { const float uu = mine + fb[lane]; const float ls = fminf(uu, 0.f) - log1pf(expf(-fabsf(uu))); LF[(size_t)m * 8 + lane] = ls; }
    }
}
__device__ __forceinline__ void fox_cumsum(const Args& a, LAS unsigned char* lds_misc, int item) {
    int tid_ = threadIdx.x; asm volatile("" : "+v"(tid_)); const int tid = tid_, lane = tid & 63, wave = tid >> 6;
    const int b = item >> 3, hd = item & 7;
    const float* LF = (const float*)(a.ws + WS_LF) + (size_t)b * SEQ * 8 + hd; float* C2 = (float*)(a.ws + WS_C2) + (size_t)item * SEQ;
    float v[8]; float run = 0.f;
#pragma unroll
    for (int i = 0; i < 8; ++i) { run += LF[(size_t)(tid * 8 + i) * 8]; v[i] = run; }
    float inc = run;
#pragma unroll
    for (int o = 1; o < 64; o <<= 1) { const float t = __shfl_up(inc, o); if (lane >= o) inc += t; }
    LAS float* wt = (LAS float*)lds_misc;
    if (lane == 63) wt[wave] = inc;
    __syncthreads();
    float pre = inc - run;
    for (int w = 0; w < wave; ++w) pre += wt[w];
#pragma unroll
    for (int i = 0; i < 8; ++i) C2[tid * 8 + i] = (pre + v[i]) * LOG2E;
    __syncthreads();
}
template <bool TO_BF16> __device__ __forceinline__ void ln_pass(const float* src, const float* gam, const float* bet, bf16* ob, float* of, int G) {
    int tid_ = threadIdx.x; asm volatile("" : "+v"(tid_)); const int tid = tid_, lane = tid & 63, wave = __builtin_amdgcn_readfirstlane(tid >> 6);
    const int gw = blockIdx.x * NWAVES + wave, NGW = G * NWAVES;
    f32x4 gv[4], bv[4];
#pragma unroll
    for (int j = 0; j < 4; ++j) { gv[j] = *(const f32x4*)(gam + 256 * j + 4 * lane); bv[j] = *(const f32x4*)(bet + 256 * j + 4 * lane); }
    for (int m = gw; m < T; m += NGW) {
        const f32x4* xr = (const f32x4*)(src + (size_t)m * D) + lane;
        f32x4 v[4]; float s = 0.f;
#pragma unroll
        for (int j = 0; j < 4; ++j) { v[j] = xr[64 * j]; s += (v[j].x + v[j].y) + (v[j].z + v[j].w); }
        const float mean = wave_sum(s) * (1.f / D); float s2 = 0.f;
#pragma unroll
        for (int j = 0; j < 4; ++j) { v[j] = v[j] - mean; s2 += (v[j].x * v[j].x + v[j].y * v[j].y) + (v[j].z * v[j].z + v[j].w * v[j].w); }
        const float rstd = 1.f / sqrtf(wave_sum(s2) * (1.f / D) + LN_EPS);
#pragma unroll
        for (int j = 0; j < 4; ++j) {
            v[j] = v[j] * rstd * gv[j] + bv[j];
            if (TO_BF16) ((unsigned long long*)(ob + (size_t)m * D) + lane)[64 * j] = (unsigned long long)pk2(v[j].x, v[j].y) | ((unsigned long long)pk2(v[j].z, v[j].w) << 32);
            else ((f32x4*)(of + (size_t)m * D) + lane)[64 * j] = v[j];
        }
    }
}
constexpr int HG_C = 32, HG_QP = 0, HG_KP = 8704, HG_KPT = 17408, HG_VT = 27648, HG_PART = 37888, HG_DEC = 39936, HG_SSQ = 40448, HG_LDS = 41472;
static_assert(HG_LDS <= RING_BYTES, "hgrn2 lds");
__device__ __forceinline__ bf16x8 cat44(bf16x4 a, bf16x4 b) { return (bf16x8){a[0], a[1], a[2], a[3], b[0], b[1], b[2], b[3]}; }
__device__ __forceinline__ bf16x8 pack8f(f32x4 a, f32x4 b) { v4u p; p.x = pk2(a[0], a[1]); p.y = pk2(a[2], a[3]); p.z = pk2(b[0], b[1]); p.w = pk2(b[2], b[3]); return __builtin_bit_cast(bf16x8, p); }
#define MFMA16(a, b, c) __builtin_amdgcn_mfma_f32_16x16x32_bf16((a), (b), (c), 0, 0, 0)
__device__ __forceinline__ void hgrn2_run(LAS unsigned char* lds, int b, int h, const bf16* QH, const bf16* GL, const bf16* VH, const bf16* GT, const float* norm_g, bf16* YA) {
    int tid_ = threadIdx.x; asm volatile("" : "+v"(tid_)); const int tid = tid_, lane = tid & 63, w = __builtin_amdgcn_readfirstlane(tid >> 6), i16 = lane & 15, g4 = lane >> 4;
    const int k = tid & 127, tq = tid >> 7;
    LAS unsigned short* Qp = (LAS unsigned short*)(lds + HG_QP);
    LAS unsigned short* Kp = (LAS unsigned short*)(lds + HG_KP);
    LAS unsigned short* KpT = (LAS unsigned short*)(lds + HG_KPT);
    LAS unsigned short* VT = (LAS unsigned short*)(lds + HG_VT);
    LAS float* part = (LAS float*)(lds + HG_PART);
    LAS float* dec = (LAS float*)(lds + HG_DEC);
    LAS float* ssq = (LAS float*)(lds + HG_SSQ);
    const size_t rowbase = (size_t)b * SEQ; const int colbase = h * 128;
    const int n = 16 * w + i16;
    const float ng = norm_g[colbase + n];
    f32x4 S[8];
#pragma unroll
    for (int i = 0; i < 8; ++i) S[i] = (f32x4){0.f, 0.f, 0.f, 0.f};
    unsigned short gr[8], qr[8], vr[8], tr[8];
#pragma unroll
    for (int i = 0; i < 8; ++i) { const size_t o = (rowbase + 8 * tq + i) * HGW + colbase + k; gr[i] = GL[o]; qr[i] = QH[o]; vr[i] = VH[o]; }
#pragma unroll
    for (int i = 0; i < 8; ++i) { const int t = 16 * (i >> 2) + 4 * g4 + (i & 3); tr[i] = GT[(rowbase + t) * HGW + colbase + n]; }
    for (int c = 0; c < SEQ / HG_C; ++c) {
        const int t0 = c * HG_C;
        const int t1 = (c + 1 < SEQ / HG_C) ? t0 + HG_C : t0;
        unsigned short gr2[8], qr2[8], vr2[8], tr2[8];
#pragma unroll
        for (int i = 0; i < 8; ++i) { const size_t o = (rowbase + t1 + 8 * tq + i) * HGW + colbase + k; gr2[i] = GL[o]; qr2[i] = QH[o]; vr2[i] = VH[o]; }
#pragma unroll
        for (int i = 0; i < 8; ++i) { const int t = 16 * (i >> 2) + 4 * g4 + (i & 3); tr2[i] = GT[(rowbase + t1 + t) * HGW + colbase + n]; }
        float gl[8], bc[8]; float run = 0.f;
#pragma unroll
        for (int i = 0; i < 8; ++i) { gl[i] = bf2f(gr[i]); run += gl[i]; bc[i] = run; }
        part[tq * 128 + k] = run;
        __syncthreads();
        const float p0 = part[k], p1 = part[128 + k], p2 = part[256 + k], p3 = part[384 + k];
        const float pre = (tq > 0 ? p0 : 0.f) + (tq > 1 ? p1 : 0.f) + (tq > 2 ? p2 : 0.f);
        unsigned short kp[8];
#pragma unroll
        for (int i = 0; i < 8; ++i) {
            const float bt = pre + bc[i]; const int t = 8 * tq + i;
            Qp[t * 136 + k] = (unsigned short)f2bf(bf2f(qr[i]) * __expf(bt));
            const float kk = (1.0f - __expf(gl[i])) * __expf(fminf(-bt, 80.f));
            kp[i] = (unsigned short)f2bf(kk); Kp[t * 136 + k] = kp[i];
        }
        { v4u o; o.x = kp[0] | ((unsigned)kp[1] << 16); o.y = kp[2] | ((unsigned)kp[3] << 16); o.z = kp[4] | ((unsigned)kp[5] << 16); o.w = kp[6] | ((unsigned)kp[7] << 16);
          *(LAS v4u*)(KpT + k * 40 + 8 * tq) = o;
          v4u q; q.x = vr[0] | ((unsigned)vr[1] << 16); q.y = vr[2] | ((unsigned)vr[3] << 16); q.z = vr[4] | ((unsigned)vr[5] << 16); q.w = vr[6] | ((unsigned)vr[7] << 16);
          *(LAS v4u*)(VT + k * 40 + 8 * tq) = q; }
        if (tq == 3) dec[k] = __expf(((p0 + p1) + (p2 + p3)));
        __syncthreads();
        f32x4 sc00 = {0.f, 0.f, 0.f, 0.f}, sc01 = sc00, sc11 = sc00;
#pragma unroll
        for (int kk = 0; kk < 4; ++kk) {
            const bf16x8 a0 = *(const LAS bf16x8*)(Kp + i16 * 136 + 32 * kk + 8 * g4), a1 = *(const LAS bf16x8*)(Kp + (16 + i16) * 136 + 32 * kk + 8 * g4);
            const bf16x8 b0 = *(const LAS bf16x8*)(Qp + i16 * 136 + 32 * kk + 8 * g4), b1 = *(const LAS bf16x8*)(Qp + (16 + i16) * 136 + 32 * kk + 8 * g4);
            sc00 = MFMA16(a0, b0, sc00); sc01 = MFMA16(a0, b1, sc01); sc11 = MFMA16(a1, b1, sc11);
        }
#pragma unroll
        for (int r = 0; r < 4; ++r) { const bool keep = (4 * g4 + r) <= i16; sc00[r] = keep ? sc00[r] : 0.f; sc11[r] = keep ? sc11[r] : 0.f; }
        const bf16x8 pa0 = pack8f(sc00, (f32x4){0.f, 0.f, 0.f, 0.f}), pa1 = pack8f(sc01, sc11);
        f32x4 o0 = {0.f, 0.f, 0.f, 0.f}, o1 = o0;
#pragma unroll
        for (int kk = 0; kk < 4; ++kk) {
            const bf16x8 Sb = pack8f(S[2 * kk], S[2 * kk + 1]);
            const bf16x8 qa0 = cat44(*(const LAS bf16x4*)(Qp + i16 * 136 + 32 * kk + 4 * g4), *(const LAS bf16x4*)(Qp + i16 * 136 + 32 * kk + 16 + 4 * g4));
            const bf16x8 qa1 = cat44(*(const LAS bf16x4*)(Qp + (16 + i16) * 136 + 32 * kk + 4 * g4), *(const LAS bf16x4*)(Qp + (16 + i16) * 136 + 32 * kk + 16 + 4 * g4));
            o0 = MFMA16(qa0, Sb, o0); o1 = MFMA16(qa1, Sb, o1);
        }
        { const bf16x8 vb = cat44(*(const LAS bf16x4*)(VT + n * 40 + 4 * g4), *(const LAS bf16x4*)(VT + n * 40 + 16 + 4 * g4));
          o0 = MFMA16(pa0, vb, o0); o1 = MFMA16(pa1, vb, o1); }
        { const bf16x8 vn = *(const LAS bf16x8*)(VT + n * 40 + 8 * g4);
#pragma unroll
          for (int tt = 0; tt < 8; ++tt) { const bf16x8 ka = *(const LAS bf16x8*)(KpT + (16 * tt + i16) * 40 + 8 * g4); S[tt] = MFMA16(ka, vn, S[tt]);
              const f32x4 dv = *(const LAS f32x4*)(dec + 16 * tt + 4 * g4); S[tt] = S[tt] * dv; } }
        f32x4 q0 = o0 * o0, q1 = o1 * o1;
#pragma unroll
        for (int off = 1; off < 16; off <<= 1) {
#pragma unroll
            for (int r = 0; r < 4; ++r) { q0[r] += __shfl_xor(q0[r], off); q1[r] += __shfl_xor(q1[r], off); } }
        if (i16 == 0) { *(LAS f32x4*)(ssq + w * 32 + 4 * g4) = q0; *(LAS f32x4*)(ssq + w * 32 + 16 + 4 * g4) = q1; }
        __syncthreads();
        f32x4 s0 = {0.f, 0.f, 0.f, 0.f}, s1 = s0;
#pragma unroll
        for (int ww = 0; ww < 8; ++ww) { s0 += *(const LAS f32x4*)(ssq + ww * 32 + 4 * g4); s1 += *(const LAS f32x4*)(ssq + ww * 32 + 16 + 4 * g4); }
#pragma unroll
        for (int r = 0; r < 4; ++r) {
            const float y0 = o0[r] * __builtin_amdgcn_rsqf(s0[r] * (1.0f / 128.0f) + RMS_EPS) * ng * bf2f(tr[r]);
            const float y1 = o1[r] * __builtin_amdgcn_rsqf(s1[r] * (1.0f / 128.0f) + RMS_EPS) * ng * bf2f(tr[4 + r]);
            YA[(rowbase + t0 + 4 * g4 + r) * HGW + colbase + n] = (unsigned short)f2bf(y0);
            YA[(rowbase + t0 + 16 + 4 * g4 + r) * HGW + colbase + n] = (unsigned short)f2bf(y1);
        }
#pragma unroll
        for (int i = 0; i < 8; ++i) { gr[i] = gr2[i]; qr[i] = qr2[i]; vr[i] = vr2[i]; tr[i] = tr2[i]; }
    }
    __syncthreads();
}
#ifndef PH_MASK
#define PH_MASK 0xfff
#endif
#define PH(k) if constexpr ((PH_MASK >> (k)) & 1)
__device__ unsigned g_bar_word[64];
__device__ __forceinline__ void grid_barrier(unsigned G) {
    asm volatile("s_waitcnt vmcnt(0)" ::: "memory");
    __syncthreads();
    if (threadIdx.x == 0) {
        __builtin_amdgcn_fence(__ATOMIC_RELEASE, "agent");
        asm volatile("s_waitcnt vmcnt(0)" ::: "memory");
        const unsigned old = __hip_atomic_fetch_add(&g_bar_word[0], 1u, __ATOMIC_RELAXED, __HIP_MEMORY_SCOPE_AGENT);
        const unsigned target = (old / G + 1u) * G;
        while ((int)(__hip_atomic_load(&g_bar_word[0], __ATOMIC_RELAXED, __HIP_MEMORY_SCOPE_AGENT) - target) < 0) __builtin_amdgcn_s_sleep(2);
    }
    __syncthreads();
    __builtin_amdgcn_fence(__ATOMIC_ACQUIRE, "agent");
    asm volatile("s_waitcnt vmcnt(0)" ::: "memory");
}
#ifndef P1_REPS
#define P1_REPS 1
#endif
#ifndef DBG_STAGE
#define DBG_STAGE 0
#define PG8_STRICT_NOTE 1
#endif
__device__ __forceinline__ void dbg_copy(const bf16* src, float* out, int G) {
    for (size_t i = (size_t)blockIdx.x * NTHR + threadIdx.x; i < (size_t)T * D / 8; i += (size_t)G * NTHR) {
        const v4u w = *(const v4u*)(src + 8 * i);
        f32x4 a = {bf2f(w.x & 0xffff), bf2f(w.x >> 16), bf2f(w.y & 0xffff), bf2f(w.y >> 16)}, b = {bf2f(w.z & 0xffff), bf2f(w.z >> 16), bf2f(w.w & 0xffff), bf2f(w.w >> 16)};
        *(f32x4*)(out + 8 * i) = a; *(f32x4*)(out + 8 * i + 4) = b; }
}
#define DBG(k, src) do { if constexpr (DBG_STAGE == (k)) { GRID_SYNC(); dbg_copy((const bf16*)(src), args.out, G); return; } } while (0)
#define GRID_SYNC() grid_barrier((unsigned)G)
__global__ void __launch_bounds__(NTHR, 2) fwd_mega(Args args) {
    extern __shared__ __attribute__((aligned(16))) unsigned char lds_raw[];
    cg::grid_group grid = cg::this_grid();
    LAS unsigned char* lds = (LAS unsigned char*)lds_raw;
    const int tid = threadIdx.x; const int G = gridDim.x;
    unsigned char* ws = args.ws;
#ifndef NONCOOP_TEST
    grid.sync();
#endif
    bf16* H = (bf16*)(ws + WS_H);
    bf16* PROJ = (bf16*)(ws + WS_PROJ);
    bf16 *QH = PROJ, *GLF = PROJ + UNIT / 2, *VHB = PROJ + 2 * (UNIT / 2), *GTB = PROJ + 3 * (UNIT / 2), *FQ = PROJ + 4 * (UNIT / 2), *FK = PROJ + 5 * (UNIT / 2), *FV = PROJ + 6 * (UNIT / 2);
    bf16 *GA = PROJ + 7 * (UNIT / 2), *GB = PROJ + 9 * (UNIT / 2);
    bf16* YA = (bf16*)(ws + WS_YA);

    PH(0) p0_prologue(args, lds, G);
    GRID_SYNC();

    DBG(1, H);
#ifdef DELAY_TEST
    { const unsigned long long t0 = __builtin_amdgcn_s_memrealtime(); while (__builtin_amdgcn_s_memrealtime() - t0 < 30000ull) __builtin_amdgcn_s_sleep(8); GRID_SYNC(); }
#endif
    PH(1) for (int it = blockIdx.x; it < BATCH * NHF; it += G) fox_cumsum(args, lds + MISC_OFF, it);
    for (int rep_ = 0; rep_ < P1_REPS; ++rep_) { if (rep_) GRID_SYNC();
    PH(2) {
        pg8::Gemm g{H, (const bf16*)(ws + WS_WIN), T, NPROJ, D}; pg8::StaticOrder S; S.init(T, NPROJ, G, (int)blockIdx.x);
        pg8::EpiProj E{PROJ, args.in[5]};
#ifdef P1_TRIVIAL
        (void)g; (void)S; (void)E;
        for (size_t i = (size_t)blockIdx.x * NTHR + threadIdx.x; i < (size_t)T * D / 8; i += (size_t)G * NTHR) { const v4u w = *(const v4u*)(H + 8 * i); v4u o; o.x = w.x ^ 0x80008000u; o.y = w.y; o.z = w.z ^ 0x80000000u; o.w = w.w; *(v4u*)(GA + 8 * i) = o; }
#else
        pg8::gemm_phase<pg8::EpiProj, pg8::StaticOrder, true, true>(lds, g, S, E);
#endif
    }
    }
    GRID_SYNC();

    DBG(2, GA);
    PH(3) for (int it = blockIdx.x; it < BATCH * 4; it += G) hgrn2_run(lds, it >> 2, it & 3, QH, GLF, VHB, GTB, args.in[6], YA);
    PH(4) {
        unsigned* ctr = (unsigned*)(ws + WS_CTL);
        volatile LAS unsigned* ub = (volatile LAS unsigned*)(lds + MISC_OFF + 64);
        const float* C2 = (const float*)(ws + WS_C2);
        for (;;) {
            if (tid == 0) ub[0] = atomicAdd(ctr, 1u);
            __syncthreads();
            const unsigned u = ub[0];
            __syncthreads();
            if (u >= (unsigned)(BATCH * NHF * 16)) break;
            const int qb = 15 - (int)(u >> 7), bh = (int)(u & 127);
            attn_body::attn_unit<8>(bh >> 3, bh & 7, qb, (const attn_body::bf16*)FQ, (const attn_body::bf16*)FK, (const attn_body::bf16*)FV, (attn_body::bf16*)FQ, C2 + (size_t)bh * SEQ, (char*)lds_raw);
        }
    }
    GRID_SYNC();

    PH(5) {
        bf16* TMP = (bf16*)(ws + WS_TMP); bf16* MG = (bf16*)(ws + WS_MERGED);
        pg8::StaticOrder S; S.init(T, D, G, (int)blockIdx.x);
        { pg8::Gemm g{YA, (const bf16*)(ws + WS_WA), T, D, HGW}; pg8::EpiGate E{TMP, GA, nullptr}; pg8::gemm_phase<pg8::EpiGate, pg8::StaticOrder, true, true>(lds, g, S, E); }
        { pg8::Gemm g{FQ, (const bf16*)(ws + WS_WB), T, D, HGW}; pg8::EpiGate E{MG, GB, TMP}; pg8::gemm_phase<pg8::EpiGate, pg8::StaticOrder, true, true>(lds, g, S, E); }
    }
    GRID_SYNC();
    DBG(3, ws + WS_MERGED);
    PH(6) {
        pg8::StaticOrder S; S.init(T, D, G, (int)blockIdx.x);
        pg8::Gemm g{(const bf16*)(ws + WS_MERGED), (const bf16*)(ws + WS_WO), T, D, D}; pg8::EpiRes<0> E{args.out, H, ALPHA};
        pg8::gemm_phase<pg8::EpiRes<0>, pg8::StaticOrder, true, true>(lds, g, S, E);
    }
    GRID_SYNC();
    PH(7) ln_pass<true>(args.out, args.in[11], args.in[12], H, nullptr, G);
    GRID_SYNC();
    DBG(5, H);
    PH(8) {
        { pg8::StaticOrder S; S.init(T, FF, G, (int)blockIdx.x); pg8::Gemm g{H, (const bf16*)(ws + WS_WFF1), T, FF, D}; pg8::EpiAct<1> E{(bf16*)(ws + WS_FF1), FF};
          pg8::gemm_phase<pg8::EpiAct<1>, pg8::StaticOrder, true, true>(lds, g, S, E); }
        { pg8::StaticOrder S; S.init(T, D, G, (int)blockIdx.x); pg8::Gemm g{(const bf16*)(ws + WS_PB), (const bf16*)(ws + WS_WP), T, D, PLE}; pg8::EpiAct<0> E{(bf16*)(ws + WS_PE), D};
          pg8::gemm_phase<pg8::EpiAct<0>, pg8::StaticOrder, true, true>(lds, g, S, E); }
    }
    GRID_SYNC();
    DBG(6, ws + WS_PE);
    PH(9) {
        pg8::StaticOrder S; S.init(T, D, G, (int)blockIdx.x);
        { pg8::Gemm g{(const bf16*)(ws + WS_FF1), (const bf16*)(ws + WS_WFF2), T, D, FF}; pg8::EpiRes<0> E{args.out, H, ALPHA}; pg8::gemm_phase<pg8::EpiRes<0>, pg8::StaticOrder, true, true>(lds, g, S, E); }
        { pg8::Gemm g{H, (const bf16*)(ws + WS_WPG), T, D, D}; pg8::EpiRes<1> E{args.out, (const bf16*)(ws + WS_PE), 0.f}; pg8::gemm_phase<pg8::EpiRes<1>, pg8::StaticOrder, true, true>(lds, g, S, E); }
    }
    GRID_SYNC();
    PH(10) ln_pass<false>(args.out, args.in[17], args.in[18], nullptr, args.out, G);
}

extern "C" void kernel_launch(void* const* d_in, const int* in_sizes, int n_in, void* d_out, int out_size, void* d_ws, size_t ws_size, hipStream_t stream) {
    static int grid = 0;
    if (grid == 0) {
        if (n_in != 19 || ws_size < WS_END) { fprintf(stderr, "kernel_launch: unexpected n_in %d / ws %zu\n", n_in, ws_size); grid = -1; return; }
        int dev = 0, cus = 0, per_cu = 0;
        (void)hipGetDevice(&dev); (void)hipDeviceGetAttribute(&cus, hipDeviceAttributeMultiprocessorCount, dev);
        if (hipFuncSetAttribute((const void*)fwd_mega, hipFuncAttributeMaxDynamicSharedMemorySize, LDS_BYTES) != hipSuccess) { fprintf(stderr, "kernel_launch: hipFuncSetAttribute failed\n"); }
        if (hipOccupancyMaxActiveBlocksPerMultiprocessor(&per_cu, (const void*)fwd_mega, NTHR, LDS_BYTES) != hipSuccess || per_cu < 1) { fprintf(stderr, "kernel_launch: occupancy query says %d\n", per_cu); per_cu = 1; }
        (void)hipGetLastError();
        grid = cus * 1;
        if (grid <= 0) grid = 256;
    }
    if (grid < 0) return;
    Args a{};
    for (int i = 0; i < 19; ++i) a.in[i] = (const float*)d_in[i];
    a.out = (float*)d_out; a.ws = (unsigned char*)d_ws;
    void* kargs[] = {&a};
#ifdef NONCOOP_TEST
    hipLaunchKernelGGL(fwd_mega, dim3(grid), dim3(NTHR), LDS_BYTES, stream, a); hipError_t e = hipPeekAtLastError(); (void)kargs;
#else
    hipError_t e = hipLaunchCooperativeKernel((const void*)fwd_mega, dim3(grid), dim3(NTHR), kargs, LDS_BYTES, stream);
#endif
    if (e != hipSuccess) fprintf(stderr, "cooperative launch failed: %s (grid %d)\n", hipGetErrorString(e), grid);
}
```

```cpp
#include <hip/hip_runtime.h>
#include <hip/hip_cooperative_groups.h>
#include <cstdio>
#include <cstdint>
namespace cg = cooperative_groups;
#define PG8_AUX 0
#define PROBE_ACT 4
namespace pg8 {
#define PG8_LAS __attribute__((address_space(3)))
typedef unsigned short bf16_t;
typedef short bf16x8 __attribute__((ext_vector_type(8)));
typedef float f32x4 __attribute__((ext_vector_type(4)));
typedef unsigned u32x4 __attribute__((ext_vector_type(4)));
constexpr int BM = 256, BK = 64, HALF = 128, HTB = HALF * BK * 2  , STAGE_BYTES = 8 * HTB, NXCD = 8, WGM = 8;

__host__ __device__ __forceinline__ int lds_byte(int r, int c) { const int st = (r >> 4) * 2 + (c >> 5), rr = r & 15, cc = c & 31, ob = rr * 64 + cc * 2; return st * 1024 + (ob ^ (((ob >> 9) & 1) << 5)); }
__host__ __device__ __forceinline__ void stage_rc(int b, int& R, int& C) { const int st = b / 1024, sb = b % 1024, swz = sb ^ (((sb >> 9) & 1) << 5); R = (st >> 1) * 16 + swz / 64; C = (st & 1) * 32 + (swz % 64) / 2; }
__host__ __device__ __forceinline__ int perm32(int rho) { const int n = rho >> 4, i = rho & 15; return 8 * (i >> 2) + 4 * n + (i & 3); }

struct Unit { int pm, pn; };
struct Gemm { const bf16_t* A; const bf16_t* Bt; int M, N, K; };

struct StaticOrder {
    int nM, nN, nwg, G, c;
    __host__ __device__ void init(int M, int N, int G_, int c_) { nM = M / BM; nN = N / BM; nwg = nM * nN; G = G_; c = c_; }
    __host__ __device__ bool next(int i, Unit& u) const {
        const long L = (long)i * G + c; if (L >= nwg) return false;
        int wgid = (int)L; { const int q = nwg / NXCD, r = nwg % NXCD, xcd = wgid % NXCD, off = wgid / NXCD; wgid = (xcd < r ? xcd * (q + 1) : r * (q + 1) + (xcd - r) * q) + off; }
        const int nig = WGM * nN, gid = wgid / nig, fm = gid * WGM, gsz = (nM - fm) < WGM ? (nM - fm) : WGM;
        u.pm = fm + ((wgid % nig) % gsz); u.pn = (wgid % nig) / gsz; return true;
    }
    __device__ __forceinline__ void a_ready(const Unit&) const {}
    __device__ __forceinline__ void done(const Unit&) const {}
};

typedef float f32x2_t __attribute__((ext_vector_type(2))); typedef __bf16 bf16x2_t __attribute__((ext_vector_type(2)));
__device__ __forceinline__ unsigned cvt_pk_bf16(float lo, float hi) { f32x2_t v = {lo, hi}; bf16x2_t b = __builtin_convertvector(v, bf16x2_t); return __builtin_bit_cast(unsigned, b); }
__device__ __forceinline__ float sigmoidf_(float x) { return __builtin_amdgcn_rcpf(1.0f + __expf(-x)); }
__device__ __forceinline__ float bflo(unsigned w) { return __uint_as_float(w << 16); }
__device__ __forceinline__ float bfhi(unsigned w) { return __uint_as_float(w & 0xffff0000u); }
#define PG8_TILE_BEGIN \
    _Pragma("unroll") for (int ai = 0; ai < 2; ++ai) _Pragma("unroll") for (int m = 0; m < 4; ++m) _Pragma("unroll") for (int bj = 0; bj < 2; ++bj) { \
        const int row = u.pm * BM + ai * HALF + wr * 64 + m * 16 + fr; const int ct = bj * HALF + wc * 32 + 8 * fq; f32x4 v0 = acc[ai][bj][m][0], v1 = acc[ai][bj][m][1];
#define PG8_TILE_END }
#define PG8_EPI_IDS int l_ = threadIdx.x; asm volatile("" : "+v"(l_)); const int fr = l_ & 15, fq = (l_ >> 4) & 3; const int wv_ = __builtin_amdgcn_readfirstlane(l_ >> 6), wr = wv_ >> 2, wc = wv_ & 3;

constexpr size_t UNIT_ELEMS = (size_t)65536 * 512;
constexpr float ATT_C2 = 0.125f * 1.4426950408889634f;
struct EpiProj {
    static constexpr bool PERM = true, AFTER_DRAIN = false;
    bf16_t* base;
    const float* hg_lb;
    template <int ACT> __device__ __forceinline__ void tile(const f32x4 (&acc)[2][2][4][2], const Unit& u, int wr, int wc, int fr, int fq, bf16_t* O, int ldc, int colt, int lbcol) const {
        float lb[2][8];
        if (ACT == 1) {
#pragma unroll
            for (int bj = 0; bj < 2; ++bj)
#pragma unroll
                for (int i = 0; i < 8; ++i) { const int c = lbcol + bj * HALF + wc * 32 + 8 * fq + i; lb[bj][i] = sigmoidf_(hg_lb[c] - hg_lb[512 + c]); }
        }
        PG8_TILE_BEGIN {
            float x[8] = {v0[0], v0[1], v0[2], v0[3], v1[0], v1[1], v1[2], v1[3]};
#pragma unroll
            for (int i = 0; i < 8; ++i) {
                if (ACT == 0) x[i] = x[i] * sigmoidf_(x[i]);
                else if (ACT == 1) { const float l = lb[bj][i]; x[i] = __logf(l + (1.0f - l) * sigmoidf_(x[i])); }
                else if (ACT == 3) x[i] = x[i] * ATT_C2;
                else if (ACT == 4) x[i] = sigmoidf_(x[i]);
            }
            u32x4 w; w.x = cvt_pk_bf16(x[0], x[1]); w.y = cvt_pk_bf16(x[2], x[3]); w.z = cvt_pk_bf16(x[4], x[5]); w.w = cvt_pk_bf16(x[6], x[7]);
            *(u32x4*)(O + (size_t)row * ldc + colt + ct) = w;
        } PG8_TILE_END
    }
    __device__ __forceinline__ void operator()(const f32x4 (&acc)[2][2][4][2], const Unit& u, int, int, int, int) const {
        PG8_EPI_IDS
        const int pn = u.pn;
        if (pn < 14) { const int g = pn >> 1; bf16_t* O = base + (size_t)g * UNIT_ELEMS; const int colt = (pn & 1) * 256;
            if (g == 0 || g == 3) tile<0>(acc, u, wr, wc, fr, fq, O, 512, colt, 0);
            else if (g == 1) tile<1>(acc, u, wr, wc, fr, fq, O, 512, colt, colt);
            else if (g == 4) tile<3>(acc, u, wr, wc, fr, fq, O, 512, colt, 0);
            else tile<2>(acc, u, wr, wc, fr, fq, O, 512, colt, 0);
        } else { const int g = (pn - 14) >> 2; bf16_t* O = base + (size_t)(7 + 2 * g) * UNIT_ELEMS; tile<PROBE_ACT>(acc, u, wr, wc, fr, fq, O, 1024, ((pn - 14) & 3) * 256, 0); }
    }
};
template <int ACT> struct EpiAct {
    static constexpr bool PERM = true, AFTER_DRAIN = false;
    bf16_t* O; int ldc;
    __device__ __forceinline__ void operator()(const f32x4 (&acc)[2][2][4][2], const Unit& u, int, int, int, int) const {
        PG8_EPI_IDS
        const int colt = u.pn * BM;
        PG8_TILE_BEGIN {
            if (ACT == 1) { v0 = __builtin_elementwise_max(v0, (f32x4){0.f, 0.f, 0.f, 0.f}); v1 = __builtin_elementwise_max(v1, (f32x4){0.f, 0.f, 0.f, 0.f}); v0 = v0 * v0; v1 = v1 * v1; }
            u32x4 w; w.x = cvt_pk_bf16(v0[0], v0[1]); w.y = cvt_pk_bf16(v0[2], v0[3]); w.z = cvt_pk_bf16(v1[0], v1[1]); w.w = cvt_pk_bf16(v1[2], v1[3]);
            *(u32x4*)(O + (size_t)row * ldc + colt + ct) = w;
        } PG8_TILE_END
    }
};
struct EpiGate {
    static constexpr bool PERM = true, AFTER_DRAIN = false;
    bf16_t* O; const bf16_t* gate; const bf16_t* add;
    __device__ __forceinline__ void operator()(const f32x4 (&acc)[2][2][4][2], const Unit& u, int, int, int, int) const {
        PG8_EPI_IDS
        const int colt = u.pn * BM;
        PG8_TILE_BEGIN {
            const size_t off = (size_t)row * 1024 + colt + ct;
            const u32x4 g = *(const u32x4*)(gate + off);
            float x[8] = {v0[0] * bflo(g.x), v0[1] * bfhi(g.x), v0[2] * bflo(g.y), v0[3] * bfhi(g.y), v1[0] * bflo(g.z), v1[1] * bfhi(g.z), v1[2] * bflo(g.w), v1[3] * bfhi(g.w)};
            if (add) { const u32x4 a = *(const u32x4*)(add + off);
                x[0] += bflo(a.x); x[1] += bfhi(a.x); x[2] += bflo(a.y); x[3] += bfhi(a.y); x[4] += bflo(a.z); x[5] += bfhi(a.z); x[6] += bflo(a.w); x[7] += bfhi(a.w); }
            u32x4 w; w.x = cvt_pk_bf16(x[0], x[1]); w.y = cvt_pk_bf16(x[2], x[3]); w.z = cvt_pk_bf16(x[4], x[5]); w.w = cvt_pk_bf16(x[6], x[7]);
            *(u32x4*)(O + off) = w;
        } PG8_TILE_END
    }
};
template <int MODE> struct EpiRes {
    static constexpr bool PERM = true, AFTER_DRAIN = false;
    float* O; const bf16_t* base; float alpha;
    __device__ __forceinline__ void operator()(const f32x4 (&acc)[2][2][4][2], const Unit& u, int, int, int, int) const {
        PG8_EPI_IDS
        const int colt = u.pn * BM;
        PG8_TILE_BEGIN {
            const size_t off = (size_t)row * 1024 + colt + ct;
            const u32x4 b = *(const u32x4*)(base + off);
            const f32x4 b0 = {bflo(b.x), bfhi(b.x), bflo(b.y), bfhi(b.y)}, b1 = {bflo(b.z), bfhi(b.z), bflo(b.w), bfhi(b.w)};
            f32x4 o0, o1;
            if (MODE == 0) { o0 = b0 * alpha + v0; o1 = b1 * alpha + v1; }
            else { const f32x4 p0 = *(const f32x4*)(O + off), p1 = *(const f32x4*)(O + off + 4);
                f32x4 s0, s1;
#pragma unroll
                for (int i = 0; i < 4; ++i) { s0[i] = sigmoidf_(v0[i]); s1[i] = sigmoidf_(v1[i]); }
                o0 = p0 + s0 * b0; o1 = p1 + s1 * b1; }
            *(f32x4*)(O + off) = o0; *(f32x4*)(O + off + 4) = o1;
        } PG8_TILE_END
    }
};
template <class Epi, class Sched, bool ALIGN_EPI = false, bool SP2 = false>
__device__ __forceinline__ void gemm_phase(PG8_LAS unsigned char* lds, const Gemm g, const Sched& S, const Epi& E) {
    int tid_ = threadIdx.x; asm volatile("" : "+v"(tid_)); const int tid = tid_, wid = __builtin_amdgcn_readfirstlane(tid >> 6), lane = tid & 63, wr = wid >> 2, wc = wid & 3, fr = lane & 15, fq = lane >> 4;
    const int K = g.K, nt = K / BK;
    unsigned voffA[2], voffB[2];
#pragma unroll
    for (int i = 0; i < 2; ++i) { int R, C; stage_rc(tid * 16 + i * 8192, R, C); const int Rb = Epi::PERM ? ((R & ~31) + perm32(R & 31)) : R;
        voffA[i] = (unsigned)(R * K + C) * 2u; voffB[i] = (unsigned)(Rb * K + C) * 2u; }
    const size_t kstep = (size_t)(BK * 2);
    const size_t hstep = (size_t)HALF * K * 2;
    const size_t tstep = 2 * hstep;
    const unsigned ldsw = (unsigned)wid * 1024u;
    const int aoff = lds_byte(wr * 64 + fr, fq * 8), boff = lds_byte(wc * 32 + fr, fq * 8);
#define PG8_SA(b, h) (((b) * 2 + (h)) * HTB)
#define PG8_SB(b, h) ((4 + (b) * 2 + (h)) * HTB)
#define PG8_STAGE(bufoff, gbase, voff) do { _Pragma("unroll") for (int _i = 0; _i < 2; ++_i) \
        __builtin_amdgcn_global_load_lds((const unsigned*)((const char*)(gbase) + (voff)[_i]), (PG8_LAS unsigned*)(lds + (bufoff) + ldsw + _i * 8192), 16, 0, PG8_AUX); } while (0)
#define PG8_LDA(dst, b, h) do { _Pragma("unroll") for (int m = 0; m < 4; ++m) _Pragma("unroll") for (int k = 0; k < 2; ++k) dst[m][k] = *(const PG8_LAS bf16x8*)(lds + PG8_SA(b, h) + aoff + m * 2048 + k * 1024); } while (0)
#define PG8_LDB(dst, b, h) do { _Pragma("unroll") for (int n = 0; n < 2; ++n) _Pragma("unroll") for (int k = 0; k < 2; ++k) dst[n][k] = *(const PG8_LAS bf16x8*)(lds + PG8_SB(b, h) + boff + n * 2048 + k * 1024); } while (0)
#define PG8_MMA(ai, bj, At, Bt) do { __builtin_amdgcn_s_setprio(1); _Pragma("unroll") for (int m = 0; m < 4; ++m) _Pragma("unroll") for (int n = 0; n < 2; ++n) _Pragma("unroll") for (int k = 0; k < 2; ++k) \
        acc[ai][bj][m][n] = __builtin_amdgcn_mfma_f32_16x16x32_bf16(Bt[n][k], At[m][k], acc[ai][bj][m][n], 0, 0, 0); __builtin_amdgcn_s_setprio(0); } while (0)
#ifdef PG8_STRICT
#define PG8_WAIT_V(n) asm volatile("s_waitcnt vmcnt(0)" ::: "memory")
#else
#define PG8_WAIT_V(n) asm volatile("s_waitcnt vmcnt(" #n ")" ::: "memory")
#endif
#define PG8_WAIT_L(n) asm volatile("s_waitcnt lgkmcnt(" #n ")" ::: "memory")
#define PG8_BAR __builtin_amdgcn_s_barrier()
#define PG8_SCHED __builtin_amdgcn_sched_barrier(0)
#ifdef PG8_SIMPLE
    {
        const unsigned lw = ldsw + (unsigned)lane * 16u;
#define PG8_GLD(dst, gbase, voff) do { _Pragma("unroll") for (int _i = 0; _i < 2; ++_i) dst[_i] = *(const u32x4*)((const char*)(gbase) + (voff)[_i]); } while (0)
#define PG8_LST(bufoff, src) do { _Pragma("unroll") for (int _i = 0; _i < 2; ++_i) *(PG8_LAS u32x4*)(lds + (bufoff) + lw + _i * 8192) = src[_i]; } while (0)
        Unit cur_;
        for (int ui_ = 0; S.next(ui_, cur_); ++ui_) {
            f32x4 acc[2][2][4][2];
#pragma unroll
            for (int a = 0; a < 2; ++a)
#pragma unroll
                for (int b = 0; b < 2; ++b)
#pragma unroll
                    for (int m = 0; m < 4; ++m)
#pragma unroll
                        for (int n = 0; n < 2; ++n) acc[a][b][m][n] = (f32x4){0.f, 0.f, 0.f, 0.f};
            bf16x8 At[4][2], B0[2][2], B1[2][2];
            u32x4 rb0[2], rb1[2], ra0[2], ra1[2];
            const char* cA = (const char*)g.A + (size_t)cur_.pm * tstep; const char* cB = (const char*)g.Bt + (size_t)cur_.pn * tstep;
            PG8_GLD(rb0, cB, voffB); PG8_GLD(rb1, cB + hstep, voffB); PG8_GLD(ra0, cA, voffA); PG8_GLD(ra1, cA + hstep, voffA);
            PG8_LST(PG8_SB(0, 0), rb0); PG8_LST(PG8_SB(0, 1), rb1); PG8_LST(PG8_SA(0, 0), ra0); PG8_LST(PG8_SA(0, 1), ra1);
            __syncthreads();
#define PG8_HALFSTEP(B_, NB_, tt) do { \
                const bool more_ = (tt) + 1 < nt; const char* a1 = cA + (size_t)((tt) + 1) * kstep; const char* b1 = cB + (size_t)((tt) + 1) * kstep; \
                if (more_) { PG8_GLD(rb0, b1, voffB); PG8_GLD(rb1, b1 + hstep, voffB); } \
                PG8_LDB(B0, B_, 0); PG8_LDB(B1, B_, 1); PG8_LDA(At, B_, 0); PG8_MMA(0, 0, At, B0); PG8_MMA(0, 1, At, B1); \
                if (more_) { PG8_LST(PG8_SB(NB_, 0), rb0); PG8_LST(PG8_SB(NB_, 1), rb1); PG8_GLD(rb0, a1, voffA); PG8_GLD(rb1, a1 + hstep, voffA); } \
                PG8_LDA(At, B_, 1); PG8_MMA(1, 0, At, B0); PG8_MMA(1, 1, At, B1); \
                if (more_) { PG8_LST(PG8_SA(NB_, 0), rb0); PG8_LST(PG8_SA(NB_, 1), rb1); } \
                __syncthreads(); } while (0)
            for (int t = 0; t < nt; t += 2) { PG8_HALFSTEP(0, 1, t); PG8_HALFSTEP(1, 0, t + 1); }
#undef PG8_HALFSTEP
            E(acc, cur_, wr, wc, fr, fq);
        }
#undef PG8_GLD
#undef PG8_LST
    }
#else
    Unit cur, nxt; int ui = 0;
    if (!S.next(0, cur)) return;
    f32x4 acc[2][2][4][2];
#pragma unroll
    for (int a = 0; a < 2; ++a)
#pragma unroll
        for (int b = 0; b < 2; ++b)
#pragma unroll
            for (int m = 0; m < 4; ++m)
#pragma unroll
                for (int n = 0; n < 2; ++n) acc[a][b][m][n] = (f32x4){0.f, 0.f, 0.f, 0.f};
    bf16x8 At[4][2], B0[2][2], B1[2][2];
    const char* cA = (const char*)g.A + (size_t)cur.pm * tstep; const char* cB = (const char*)g.Bt + (size_t)cur.pn * tstep;
    S.a_ready(cur);
    if constexpr (SP2) {
        PG8_STAGE(PG8_SB(0, 0), cB, voffB); PG8_STAGE(PG8_SB(0, 1), cB + hstep, voffB); PG8_STAGE(PG8_SA(0, 0), cA, voffA); PG8_STAGE(PG8_SA(0, 1), cA + hstep, voffA);
        if (wr == 1) PG8_BAR;
        PG8_WAIT_V(2); PG8_BAR;
        PG8_STAGE(PG8_SB(1, 0), cB + kstep, voffB); PG8_STAGE(PG8_SA(1, 0), cA + kstep, voffA); PG8_STAGE(PG8_SB(1, 1), cB + hstep + kstep, voffB);
        PG8_WAIT_V(6); PG8_BAR;
    } else {
        PG8_STAGE(PG8_SB(0, 0), cB, voffB); PG8_STAGE(PG8_SA(0, 0), cA, voffA); PG8_STAGE(PG8_SB(0, 1), cB + hstep, voffB); PG8_STAGE(PG8_SA(0, 1), cA + hstep, voffA);
        if (wr == 1) PG8_BAR;
        PG8_WAIT_V(4); PG8_BAR;
        PG8_STAGE(PG8_SB(1, 0), cB + kstep, voffB); PG8_STAGE(PG8_SA(1, 0), cA + kstep, voffA); PG8_STAGE(PG8_SB(1, 1), cB + hstep + kstep, voffB);
        PG8_WAIT_V(6); PG8_BAR;
    }
    for (;;) {
        const bool has_next = S.next(ui + 1, nxt);
        const char* nA = has_next ? (const char*)g.A + (size_t)nxt.pm * tstep : cA; const char* nB = has_next ? (const char*)g.Bt + (size_t)nxt.pn * tstep : cB;
        for (int t = 0; t < nt; t += 2) {
            const bool last = (t == nt - 2);
            const char* a1 = cA + (size_t)(t + 1) * kstep;
            const char* a2 = last ? nA : cA + (size_t)(t + 2) * kstep; const char* b2 = last ? nB : cB + (size_t)(t + 2) * kstep;
            const char* a3 = a2 + kstep; const char* b3 = b2 + kstep;
            if (last && has_next) S.a_ready(nxt);
            if constexpr (SP2) {
            PG8_LDB(B0, 0, 0); PG8_LDB(B1, 0, 1); PG8_SCHED; PG8_LDA(At, 0, 0); PG8_STAGE(PG8_SA(1, 1), a1 + hstep, voffA);
            PG8_WAIT_V(8); PG8_WAIT_L(0); PG8_BAR; PG8_MMA(0, 0, At, B0); PG8_MMA(0, 1, At, B1); PG8_BAR; PG8_SCHED;
            PG8_LDA(At, 0, 1); PG8_STAGE(PG8_SB(0, 0), b2, voffB); PG8_STAGE(PG8_SB(0, 1), b2 + hstep, voffB); PG8_STAGE(PG8_SA(0, 0), a2, voffA);
            PG8_WAIT_V(8); PG8_WAIT_L(0); PG8_BAR; PG8_MMA(1, 0, At, B0); PG8_MMA(1, 1, At, B1); PG8_BAR; PG8_SCHED;
            PG8_LDB(B0, 1, 0); PG8_LDB(B1, 1, 1); PG8_SCHED; PG8_LDA(At, 1, 0); PG8_STAGE(PG8_SA(0, 1), a2 + hstep, voffA);
            PG8_WAIT_V(8); PG8_WAIT_L(0); PG8_BAR; PG8_MMA(0, 0, At, B0); PG8_MMA(0, 1, At, B1); PG8_BAR; PG8_SCHED;
            PG8_LDA(At, 1, 1); PG8_STAGE(PG8_SB(1, 0), b3, voffB); PG8_STAGE(PG8_SB(1, 1), b3 + hstep, voffB); PG8_STAGE(PG8_SA(1, 0), a3, voffA);
            PG8_WAIT_V(8); PG8_WAIT_L(0); PG8_BAR; PG8_MMA(1, 0, At, B0); PG8_MMA(1, 1, At, B1); PG8_BAR; PG8_SCHED;
            } else {
            PG8_LDB(B0, 0, 0); PG8_SCHED; PG8_LDA(At, 0, 0); PG8_STAGE(PG8_SA(1, 1), a1 + hstep, voffA);
            PG8_WAIT_L(8); PG8_BAR; PG8_WAIT_L(0); PG8_MMA(0, 0, At, B0); PG8_BAR; PG8_SCHED;
            PG8_LDB(B1, 0, 1); PG8_STAGE(PG8_SB(0, 0), b2, voffB);
            PG8_BAR; PG8_WAIT_L(0); PG8_MMA(0, 1, At, B1); PG8_BAR;
            PG8_LDA(At, 0, 1); PG8_STAGE(PG8_SA(0, 0), a2, voffA);
            PG8_BAR; PG8_WAIT_L(0); PG8_MMA(1, 0, At, B0); PG8_BAR; PG8_SCHED;
            PG8_STAGE(PG8_SB(0, 1), b2 + hstep, voffB);
            PG8_WAIT_V(6); PG8_BAR; PG8_MMA(1, 1, At, B1); PG8_BAR;
            PG8_LDB(B0, 1, 0); PG8_SCHED; PG8_LDA(At, 1, 0); PG8_STAGE(PG8_SA(0, 1), a2 + hstep, voffA);
            PG8_WAIT_L(8); PG8_BAR; PG8_WAIT_L(0); PG8_MMA(0, 0, At, B0); PG8_BAR; PG8_SCHED;
            PG8_LDB(B1, 1, 1); PG8_STAGE(PG8_SB(1, 0), b3, voffB);
            PG8_BAR; PG8_WAIT_L(0); PG8_MMA(0, 1, At, B1); PG8_BAR;
            PG8_LDA(At, 1, 1); PG8_STAGE(PG8_SA(1, 0), a3, voffA);
            PG8_BAR; PG8_WAIT_L(0); PG8_MMA(1, 0, At, B0); PG8_BAR; PG8_SCHED;
            PG8_STAGE(PG8_SB(1, 1), b3 + hstep, voffB);
            PG8_WAIT_V(6); PG8_BAR; PG8_MMA(1, 1, At, B1); PG8_BAR;
            }
        }
        if constexpr (ALIGN_EPI) { if (wr == 0) PG8_BAR; }
        if constexpr (!Epi::AFTER_DRAIN) { E(acc, cur, wr, wc, fr, fq); S.done(cur); }
        if (!has_next) break;
#pragma unroll
        for (int a = 0; a < 2; ++a)
#pragma unroll
            for (int b = 0; b < 2; ++b)
#pragma unroll
                for (int m = 0; m < 4; ++m)
#pragma unroll
                    for (int n = 0; n < 2; ++n) acc[a][b][m][n] = (f32x4){0.f, 0.f, 0.f, 0.f};
        cur = nxt; cA = nA; cB = nB; ++ui;
        if constexpr (ALIGN_EPI) { if (wr == 1) PG8_BAR; }
    }
    PG8_WAIT_V(0);
    if constexpr (!ALIGN_EPI) { if (wr == 0) PG8_BAR; }
    PG8_BAR;
    if constexpr (Epi::AFTER_DRAIN) { E.fused(acc, cur, wr, wc, fr, fq, lds, wid, lane); S.done(cur); }
#endif
#undef PG8_SA
#undef PG8_SB
#undef PG8_STAGE
#undef PG8_LDA
#undef PG8_LDB
#undef PG8_MMA
#undef PG8_WAIT_V
#undef PG8_WAIT_L
#undef PG8_BAR
#undef PG8_SCHED
}
}
#include <hip/hip_bf16.h>
#include <cmath>
namespace attn_body {
using bf16=__hip_bfloat16;
using bf16x8=__attribute__((ext_vector_type(8)))short;
using s16x4=__attribute__((ext_vector_type(4)))short;
using f32x16=__attribute__((ext_vector_type(16)))float;
using u32x4=__attribute__((ext_vector_type(4)))unsigned;
using f32x4v=__attribute__((ext_vector_type(4)))float;
constexpr int BATCH=16,NHEAD=8,SEQ=4096,D=64,DM=NHEAD*D;
constexpr int NW=8,QBLK=32,QB=QBLK*NW,KVBLK=64,NQB=SEQ/QB;
constexpr int ATTN_PITCH=DM, ATTN_UNIT_ROWS=QB;
__device__ __forceinline__ int crow(int r,int hi){return (r&3)+8*(r>>2)+4*hi;}
#define SBAR() __builtin_amdgcn_sched_barrier(0)
__device__ __forceinline__ void cmask(f32x16&p0,f32x16&p1,int jb,int qrel,int hi){
  const float NEG=-INFINITY; int kb=64*jb+4*hi;
  #pragma unroll
  for(int r=0;r<16;++r){int kv=kb+(r&3)+8*(r>>2); if(kv>qrel)p0[r]=NEG; if(kv+32>qrel)p1[r]=NEG;}
}

constexpr int NSLOT=3, SLOTB=8192;
constexpr int LDS_K=0, LDS_V=NSLOT*SLOTB, LDS_WS=2*NSLOT*SLOTB, LDS_OST=LDS_WS+NW*64*4, LDS_CB=LDS_OST+NW*4096, LDS_BYTES=LDS_CB+SEQ*4;
constexpr float FSKIP=100.f;
constexpr float C2=0.125f*1.4426950408889634f;
__device__ __forceinline__ void glds16(const void*gsrc,unsigned lds_dst){unsigned keep;
  asm volatile("s_mov_b32 %0, m0\n\ts_mov_b32 m0, %2\n\ts_nop 0\n\tglobal_load_lds_dwordx4 %1, off\n\ts_mov_b32 m0, %0":"=&s"(keep):"v"(gsrc),"s"(lds_dst):"memory");}
__device__ __forceinline__ float max3f(float a,float b,float c){float r;asm("v_max3_f32 %0, %1, %2, %3":"=v"(r):"v"(a),"v"(b),"v"(c));return r;}
__device__ __forceinline__ float max2f(float a,float b){float r;asm("v_max_f32_e32 %0, %1, %2":"=v"(r):"v"(a),"v"(b));return r;}
__device__ __forceinline__ float fadd_s(float a,float b){float r;asm("v_add_f32_e32 %0, %1, %2":"=v"(r):"v"(a),"v"(b));return r;}
__device__ __forceinline__ float fsub_s(float a,float b){float r;asm("v_sub_f32_e32 %0, %1, %2":"=v"(r):"v"(a),"v"(b));return r;}
typedef float f32x2_t __attribute__((ext_vector_type(2))); typedef __bf16 bf16x2_t __attribute__((ext_vector_type(2)));
__device__ __forceinline__ unsigned cvtpk_s(float lo,float hi){f32x2_t v={lo,hi};bf16x2_t b=__builtin_convertvector(v,bf16x2_t);return __builtin_bit_cast(unsigned,b);}
#define WAIT_BAR(N) asm volatile("s_waitcnt vmcnt(" #N ") lgkmcnt(0)\n\ts_barrier":::"memory")

__device__ __forceinline__ void qkt(f32x16&p0,f32x16&p1,const char*Kslot,const bf16x8*qr,const f32x16&negm,int r32,int hi){
  const char*kb=Kslot+hi*1024+r32*16;
  #pragma unroll
  for(int d0=0;d0<4;++d0){
    const bf16x8 b0=*reinterpret_cast<const bf16x8*>(kb+d0*2048);
    const bf16x8 b1=*reinterpret_cast<const bf16x8*>(kb+d0*2048+512);
    if(d0==0){p0=__builtin_amdgcn_mfma_f32_32x32x16_bf16(b0,qr[0],negm,0,0,0);p1=__builtin_amdgcn_mfma_f32_32x32x16_bf16(b1,qr[0],negm,0,0,0);}
    else{p0=__builtin_amdgcn_mfma_f32_32x32x16_bf16(b0,qr[d0],p0,0,0,0);p1=__builtin_amdgcn_mfma_f32_32x32x16_bf16(b1,qr[d0],p1,0,0,0);}}
}
typedef __attribute__((address_space(3))) const char* lds_cptr;
typedef short v4i16_t __attribute__((ext_vector_type(4)));
__device__ __forceinline__ void kload8(bf16x8*kf,lds_cptr kp){
  kf[0]=*(const __attribute__((address_space(3))) bf16x8*)(kp);      kf[1]=*(const __attribute__((address_space(3))) bf16x8*)(kp+512);
  kf[2]=*(const __attribute__((address_space(3))) bf16x8*)(kp+2048); kf[3]=*(const __attribute__((address_space(3))) bf16x8*)(kp+2560);
  kf[4]=*(const __attribute__((address_space(3))) bf16x8*)(kp+4096); kf[5]=*(const __attribute__((address_space(3))) bf16x8*)(kp+4608);
  kf[6]=*(const __attribute__((address_space(3))) bf16x8*)(kp+6144); kf[7]=*(const __attribute__((address_space(3))) bf16x8*)(kp+6656);
}
__device__ __forceinline__ void kload2(bf16x8*kf,lds_cptr kp,int j){ kf[2*j]=*(const __attribute__((address_space(3))) bf16x8*)(kp+j*2048); kf[2*j+1]=*(const __attribute__((address_space(3))) bf16x8*)(kp+j*2048+512); }
__device__ __forceinline__ s16x4 vtr(lds_cptr p){ return __builtin_bit_cast(s16x4,__builtin_amdgcn_ds_read_tr16_b64_v4i16((__attribute__((address_space(3))) v4i16_t*)p)); }
__device__ __forceinline__ float rowmax(const f32x16&p0,const f32x16&p1){
  float a=max3f(p0[0],p0[1],p1[0]),b=max3f(p0[2],p0[3],p1[1]);a=max3f(a,p1[2],p1[3]);
  #pragma unroll
  for(int r=4;r<16;r+=4){a=max3f(a,p0[r],p0[r+1]);b=max3f(b,p0[r+2],p0[r+3]);a=max3f(a,p1[r],p1[r+1]);b=max3f(b,p1[r+2],p1[r+3]);}
  const float m=max2f(a,b);
  auto rr=__builtin_amdgcn_permlane32_swap(__float_as_uint(m),__float_as_uint(m),false,false);
  return max2f(__uint_as_float(rr[0]),__uint_as_float(rr[1]));
}
__device__ __forceinline__ void pv(f32x16*o,int vb,bf16x8 pa0,bf16x8 pa1,bf16x8 pa2,bf16x8 pa3){
  #pragma unroll
  for(int d0=0;d0<2;++d0){s16x4 lo[4],hi[4];
    #pragma unroll
    for(int ks=0;ks<4;++ks){
      asm volatile("ds_read_b64_tr_b16 %0,%1 offset:%c2":"=&v"(lo[ks]):"v"(vb),"i"(d0*4096+ks*1024):"memory");
      asm volatile("ds_read_b64_tr_b16 %0,%1 offset:%c2":"=&v"(hi[ks]):"v"(vb),"i"(d0*4096+ks*1024+512):"memory");}
    asm volatile("s_waitcnt lgkmcnt(0)":::"memory");SBAR();
    #define PK(k) (bf16x8){lo[k][0],lo[k][1],lo[k][2],lo[k][3],hi[k][0],hi[k][1],hi[k][2],hi[k][3]}
    o[d0]=__builtin_amdgcn_mfma_f32_32x32x16_bf16(pa0,PK(0),o[d0],0,0,0);
    o[d0]=__builtin_amdgcn_mfma_f32_32x32x16_bf16(pa1,PK(1),o[d0],0,0,0);
    o[d0]=__builtin_amdgcn_mfma_f32_32x32x16_bf16(pa2,PK(2),o[d0],0,0,0);
    o[d0]=__builtin_amdgcn_mfma_f32_32x32x16_bf16(pa3,PK(3),o[d0],0,0,0);
    #undef PK
  }
}

#ifndef ATTN_STORE16
#define ATTN_STORE16(p,v) (*(u32x4*)(p)=(v))
#endif
template<int THRL> __device__ __forceinline__ void attn_unit(int b,int h,int qb,const bf16*Q,const bf16*__restrict__ K,const bf16*__restrict__ V,bf16*O,const float*__restrict__ Cbh,char*shm){
  int tid_=threadIdx.x; asm volatile("":"+v"(tid_));
  const int tid=tid_,lane=tid&63,r32=lane&31,hi=lane>>5; const int wid=__builtin_amdgcn_readfirstlane(tid>>6);
  const long rowbase=(long)b*SEQ; const int q0=qb*QB;
  int t0;
  { const int NTf=(q0+QB)/KVBLK; const float cref=Cbh[q0]; const float ce=(lane<NTf)?Cbh[64*lane+63]:cref;
    const unsigned long long sk=__ballot((lane<NTf)&&((cref-ce)<-FSKIP));
    int t_=(int)__builtin_popcountll(sk); t_=(t_<NTf-4?t_:NTf-4)&~1; t0=__builtin_amdgcn_readfirstlane(t_); }
  const bf16*Qw=Q+(rowbase+q0+wid*QBLK)*DM+h*D;
  const bf16*Kh=K+(rowbase+(long)t0*KVBLK)*DM+h*D,*Vh=V+(rowbase+(long)t0*KVBLK)*DM+h*D;
  const unsigned lds0=(unsigned)(uintptr_t)shm;
  float*wsf=(float*)(shm+LDS_WS)+wid*64;
  const bf16*ksrc=Kh+(long)lane*DM+wid*8;
  const bf16*vsrc=Vh+(long)(16*(wid&3)+(lane>>2))*DM+(wid>>2)*32+(lane&3)*8;
  const unsigned kdst=lds0+LDS_K+wid*1024, vdst=lds0+LDS_V+wid*1024;
  #define DMA_K(t,slot) glds16(ksrc+(long)(t)*KVBLK*DM,(unsigned)__builtin_amdgcn_readfirstlane(kdst+(slot)))
  #define DMA_V(t,slot) glds16(vsrc+(long)(t)*KVBLK*DM,(unsigned)__builtin_amdgcn_readfirstlane(vdst+(slot)))
  const int vb0=(int)(lds0+LDS_V)+((lane>>4)&1)*32+(lane&3)*8+(4*hi+((lane&15)>>2))*64;
  const char*Kbase=shm+LDS_K; bf16x8 kf[8];
  const lds_cptr shm3=(lds_cptr)shm; const lds_cptr kp0=shm3+LDS_K+hi*1024+r32*16; const lds_cptr vp0=shm3+LDS_V+((lane>>4)&1)*32+(lane&3)*8+(4*hi+((lane&15)>>2))*64;
  const int NT=(q0+QB)/KVBLK-t0;
  typedef __attribute__((address_space(3))) f32x4v* cb_wptr; typedef __attribute__((address_space(3))) const f32x4v* cb_lptr;
  float cq2;
  { const float c2ref=Cbh[q0]; const int nk4=(q0+QB-t0*KVBLK)>>2; const float*Cs=Cbh+t0*KVBLK; cb_wptr cw=(cb_wptr)((__attribute__((address_space(3))) char*)shm+LDS_CB);
    for(int i=tid;i<nk4;i+=NW*64){ f32x4v v=*(const f32x4v*)(Cs+4*i); v=v-c2ref; cw[i]=v; }
    cq2=Cbh[q0+wid*QBLK+r32]-c2ref;
    asm volatile("s_waitcnt vmcnt(0) lgkmcnt(0)":::"memory"); }
  DMA_K(0,0);DMA_V(0,0);DMA_K(1,SLOTB);
  bf16x8 qr[4];
  #pragma unroll
  for(int d0=0;d0<4;++d0)qr[d0]=*reinterpret_cast<const bf16x8*>(&Qw[(long)r32*DM+d0*16+hi*8]);
  float mhat=0.f,l_reg=0.f;f32x16 o[2];o[0]=f32x16{};o[1]=f32x16{};const f32x16 zz16=f32x16{}; float mq=-cq2;
  const int qrel=wid*QBLK+r32;
  #define CMASK(P0,P1,t) do{int jb_=(t)-(NT-4); if(jb_>=0)cmask(P0,P1,jb_,qrel,hi);}while(0)
  const cb_lptr cb0=(cb_lptr)((__attribute__((address_space(3))) const char*)shm+LDS_CB+hi*16);
  #define BIAS(P0,P1,t) do{ const cb_lptr cp_=cb0+(t)*16; \
    _Pragma("unroll") for(int h_=0;h_<2;++h_){ \
    _Pragma("unroll") for(int j_=2*h_;j_<2*h_+2;++j_){ const f32x4v a_=cp_[2*j_]+mq, b_=cp_[8+2*j_]+mq; \
      P0[4*j_]-=a_[0];P0[4*j_+1]-=a_[1];P0[4*j_+2]-=a_[2];P0[4*j_+3]-=a_[3]; P1[4*j_]-=b_[0];P1[4*j_+1]-=b_[1];P1[4*j_+2]-=b_[2];P1[4*j_+3]-=b_[3]; } SBAR(); } }while(0)
  bool resc=false;
  #define START(P0,P1) do{ const float rm=__builtin_fmaxf(rowmax(P0,P1),0.f); resc=false; \
    { const float dl=rm; mhat=fadd_s(mhat,dl); \
      _Pragma("unroll") for(int r=0;r<16;++r){P0[r]=fsub_s(P0[r],dl);P1[r]=fsub_s(P1[r],dl);} \
      mq=mhat-cq2; } \
    _Pragma("unroll") for(int r=0;r<16;++r)P0[r]=__builtin_amdgcn_exp2f(P0[r]); }while(0)
  #define RESC() do{ if(resc){ asm volatile("s_waitcnt lgkmcnt(0)":::"memory"); \
      _Pragma("unroll") for(int d_=0;d_<2;++d_) _Pragma("unroll") for(int r=0;r<16;++r)o[d_][r]*=wsf[crow(r,hi)]; } }while(0)
  f32x16 pA0,pA1,pB0,pB1;
  int sl_prev=0,sl_cur=0,sl_next=SLOTB;
  #define ROT() do{sl_prev=sl_cur;sl_cur=sl_next;sl_next=(sl_next==(NSLOT-1)*SLOTB)?0:sl_next+SLOTB;}while(0)
  DMA_K(2,2*SLOTB);
  WAIT_BAR(3);
  qkt(pA0,pA1,Kbase,qr,zz16,r32,hi);asm volatile("s_nop 15\n\ts_nop 7":"+v"(pA0),"+v"(pA1));BIAS(pA0,pA1,0);CMASK(pA0,pA1,0);
  START(pA0,pA1);
  _Pragma("unroll") for(int r=0;r<16;++r)pA1[r]=__builtin_amdgcn_exp2f(pA1[r]);
  WAIT_BAR(0);
  DMA_K(3,0);DMA_V(1,SLOTB);
  ROT();
  kload8(kf,kp0+sl_cur);
  WAIT_BAR(2);
  s16x4 vlo[8],vhi[8]; u32x4 pw0,pw1,pw2,pw3;
  #define PKW(P,B) cvtpk_s(P[B],P[B+1])
  #define PAF(k) __builtin_bit_cast(bf16x8,pw##k)
  #define VFR(i) (bf16x8){vlo[i][0],vlo[i][1],vlo[i][2],vlo[i][3],vhi[i][0],vhi[i][1],vhi[i][2],vhi[i][3]}
  #define PIN(x) asm volatile("":"+v"(x))
  #define MX3(a,b,c) __builtin_fmaxf(__builtin_fmaxf((a),(b)),(c))
  #define GAPA(MF,A0,A1,A2,A3,W0,W1,PW) do{ MF; sacc+=A0; sacc+=A1; sacc+=A2; sacc+=A3; PIN(sacc); W0; W1; PIN(PW); SBAR(); }while(0)
  #define EX(v) __builtin_amdgcn_exp2f(v)
  #define GAPB(MF,X,B) do{ MF; X[B]=EX(X[B]); X[B+1]=EX(X[B+1]); X[B+2]=EX(X[B+2]); X[B+3]=EX(X[B+3]); PIN(X); SBAR(); }while(0)
  #define VRD(i) do{ vlo[i]=vtr(vp_+(((i)>>2)*4096+((i)&3)*1024)); vhi[i]=vtr(vp_+(((i)>>2)*4096+((i)&3)*1024+512)); }while(0)
  #define KRD(G,j) do{ if(G){ kload2(kf,kp0+sl_next,j); SBAR(); } }while(0)
  #define STEP(C0,C1,P0,P1,t,GK,GV,GL) do{ SBAR(); \
    const lds_cptr vp_=vp0+sl_prev; \
    VRD(0); SBAR(); float sacc=(P0[0]+P0[1]); \
    GAPA(C0=__builtin_amdgcn_mfma_f32_32x32x16_bf16(kf[0],qr[0],zz16,0,0,0), P0[2],P0[3],P0[4],P0[5],     pw0[0]=PKW(P0,0), pw0[1]=PKW(P0,2), pw0); \
    VRD(4); SBAR(); GAPA(C1=__builtin_amdgcn_mfma_f32_32x32x16_bf16(kf[1],qr[0],zz16,0,0,0), P0[6],P0[7],P0[8],P0[9],     pw0[2]=PKW(P0,4), pw0[3]=PKW(P0,6), pw0); \
    VRD(1); SBAR(); GAPA(C0=__builtin_amdgcn_mfma_f32_32x32x16_bf16(kf[2],qr[1],C0,0,0,0),   P0[10],P0[11],P0[12],P0[13], pw1[0]=PKW(P0,8), pw1[1]=PKW(P0,10), pw1); \
    VRD(5); SBAR(); GAPA(C1=__builtin_amdgcn_mfma_f32_32x32x16_bf16(kf[3],qr[1],C1,0,0,0),   P0[14],P0[15],P1[0],P1[1],   pw1[2]=PKW(P0,12),pw1[3]=PKW(P0,14), pw1); \
    VRD(2); SBAR(); GAPA(C0=__builtin_amdgcn_mfma_f32_32x32x16_bf16(kf[4],qr[2],C0,0,0,0),   P1[2],P1[3],P1[4],P1[5],     pw2[0]=PKW(P1,0), pw2[1]=PKW(P1,2), pw2); \
    VRD(6); SBAR(); GAPA(C1=__builtin_amdgcn_mfma_f32_32x32x16_bf16(kf[5],qr[2],C1,0,0,0),   P1[6],P1[7],P1[8],P1[9],     pw2[2]=PKW(P1,4), pw2[3]=PKW(P1,6), pw2); \
    VRD(3); SBAR(); GAPA(C0=__builtin_amdgcn_mfma_f32_32x32x16_bf16(kf[6],qr[3],C0,0,0,0),   P1[10],P1[11],P1[12],P1[13], pw3[0]=PKW(P1,8), pw3[1]=PKW(P1,10), pw3); \
    VRD(7); SBAR(); GAPA(C1=__builtin_amdgcn_mfma_f32_32x32x16_bf16(kf[7],qr[3],C1,0,0,0),   P1[14],P1[15],0.f,0.f,       pw3[2]=PKW(P1,12),pw3[3]=PKW(P1,14), pw3); \
    l_reg+=sacc; \
    if(GK){DMA_K((t)+3,sl_cur);} if(GV){DMA_V((t)+1,sl_next);} \
    BIAS(C0,C1,t); CMASK(C0,C1,t); \
    { float a=MX3(C0[0],C0[1],C1[0]),b=MX3(C0[2],C0[3],C1[1]); a=MX3(a,C1[2],C1[3]); \
      _Pragma("unroll") for(int r=4;r<16;r+=4){a=MX3(a,C0[r],C0[r+1]);b=MX3(b,C0[r+2],C0[r+3]);a=MX3(a,C1[r],C1[r+1]);b=MX3(b,C1[r+2],C1[r+3]);} \
      float rm=__builtin_fmaxf(a,b); { auto rr=__builtin_amdgcn_permlane32_swap(__float_as_uint(rm),__float_as_uint(rm),false,false); rm=__builtin_fmaxf(__uint_as_float(rr[0]),__uint_as_float(rr[1])); } \
      resc=false; \
      if(__builtin_expect(__any(rm>(float)THRL),0)){ const float dl=__builtin_fmaxf(rm,0.f); mhat+=dl; \
        _Pragma("unroll") for(int r=0;r<16;++r){C0[r]-=dl;C1[r]-=dl;} \
        mq=mhat-cq2; \
        const float f=__builtin_amdgcn_exp2f(-dl); l_reg*=f; if(hi==0)wsf[r32]=f; resc=true; } } \
    SBAR(); \
    GAPB(o[0]=__builtin_amdgcn_mfma_f32_32x32x16_bf16(PAF(0),VFR(0),o[0],0,0,0), C0,0); \
    GAPB(o[1]=__builtin_amdgcn_mfma_f32_32x32x16_bf16(PAF(0),VFR(4),o[1],0,0,0), C0,4); \
    KRD(GL,0); GAPB(o[0]=__builtin_amdgcn_mfma_f32_32x32x16_bf16(PAF(1),VFR(1),o[0],0,0,0), C0,8); \
    KRD(GL,1); GAPB(o[1]=__builtin_amdgcn_mfma_f32_32x32x16_bf16(PAF(1),VFR(5),o[1],0,0,0), C0,12); \
    KRD(GL,2); GAPB(o[0]=__builtin_amdgcn_mfma_f32_32x32x16_bf16(PAF(2),VFR(2),o[0],0,0,0), C1,0); \
    KRD(GL,3); GAPB(o[1]=__builtin_amdgcn_mfma_f32_32x32x16_bf16(PAF(2),VFR(6),o[1],0,0,0), C1,4); \
    GAPB(o[0]=__builtin_amdgcn_mfma_f32_32x32x16_bf16(PAF(3),VFR(3),o[0],0,0,0), C1,8); \
    GAPB(o[1]=__builtin_amdgcn_mfma_f32_32x32x16_bf16(PAF(3),VFR(7),o[1],0,0,0), C1,12); \
    }while(0)
  int t=1;
  #undef CMASK
  #define CMASK(P0,P1,t) do{}while(0)
  for(;t+5<NT;t+=2){
    STEP(pB0,pB1,pA0,pA1,t,true,true,true);     WAIT_BAR(2); RESC(); ROT();
    STEP(pA0,pA1,pB0,pB1,t+1,true,true,true);   WAIT_BAR(2); RESC(); ROT();
  }
  #undef CMASK
  #define CMASK(P0,P1,t) do{int jb_=(t)-(NT-4); if(jb_>=0)cmask(P0,P1,jb_,qrel,hi);}while(0)
  #define ENDW(tt) do{ if((tt)+3<NT){WAIT_BAR(2);} else if((tt)+2<NT){WAIT_BAR(1);} else {WAIT_BAR(0);} }while(0)
  for(;t+1<NT;t+=2){
    STEP(pB0,pB1,pA0,pA1,t,(t+3<NT),(t+1<NT),(t+1<NT));       ENDW(t);   RESC(); ROT();
    STEP(pA0,pA1,pB0,pB1,t+1,(t+4<NT),(t+2<NT),(t+2<NT));     ENDW(t+1); RESC(); ROT();
  }
  STEP(pB0,pB1,pA0,pA1,NT-1,false,false,false); RESC();
  { float sacc=pB0[0]+pB0[1]; _Pragma("unroll") for(int r=2;r<16;++r)sacc+=pB0[r]; _Pragma("unroll") for(int r=0;r<16;++r)sacc+=pB1[r]; l_reg+=sacc;
    pw0=(u32x4){PKW(pB0,0),PKW(pB0,2),PKW(pB0,4),PKW(pB0,6)};pw1=(u32x4){PKW(pB0,8),PKW(pB0,10),PKW(pB0,12),PKW(pB0,14)};pw2=(u32x4){PKW(pB1,0),PKW(pB1,2),PKW(pB1,4),PKW(pB1,6)};pw3=(u32x4){PKW(pB1,8),PKW(pB1,10),PKW(pB1,12),PKW(pB1,14)};
    SBAR(); pv(o,vb0+sl_cur,PAF(0),PAF(1),PAF(2),PAF(3)); }
  #undef PKW
  #undef PAF
  #undef VFR
  #undef PIN
  #undef MX3
  #undef GAPA
  #undef GAPB
  #undef EX
  #undef VRD
  #undef KRD
  #undef STEP
  #undef ENDW
  {auto rr=__builtin_amdgcn_permlane32_swap(__float_as_uint(l_reg),__float_as_uint(l_reg),false,false);l_reg=__uint_as_float(rr[0])+__uint_as_float(rr[1]);}
  if(hi==0)wsf[32+r32]=l_reg;asm volatile("s_waitcnt lgkmcnt(0)":::"memory");
  float rli[16];
  #pragma unroll
  for(int r=0;r<16;++r)rli[r]=__builtin_amdgcn_rcpf(wsf[32+crow(r,hi)]);
  bf16*Ow=O+(rowbase+q0+wid*QBLK)*DM+h*D;
  { bf16*stg=(bf16*)(shm+LDS_OST)+wid*2048;
    #pragma unroll
    for(int r=0;r<16;++r){const int orow=crow(r,hi);
      #pragma unroll
      for(int d0=0;d0<2;++d0)stg[orow*64+d0*32+r32]=__float2bfloat16(o[d0][r]*rli[r]);}
    asm volatile("s_waitcnt lgkmcnt(0)":::"memory");
    #pragma unroll
    for(int i=0;i<4;++i){const int row=i*8+(lane>>3),ch=lane&7; const u32x4 v=*(const u32x4*)(stg+row*64+ch*8); ATTN_STORE16(Ow+(long)row*DM+ch*8,v);} }
  asm volatile("s_waitcnt lgkmcnt(0)\n\ts_barrier":::"memory");
  #undef BIAS
  #undef DMA_K
  #undef DMA_V
  #undef CMASK
  #undef START
  #undef RESC
  #undef ROT
}
constexpr int ATTN_LDS_BYTES=LDS_BYTES;
#undef SBAR
#undef WAIT_BAR
}
#define LAS __attribute__((address_space(3)))
typedef unsigned short bf16;
typedef float f32x4 __attribute__((ext_vector_type(4)));
typedef unsigned v4u __attribute__((ext_vector_type(4)));
typedef unsigned v2u __attribute__((ext_vector_type(2)));
typedef short bf16x8 __attribute__((ext_vector_type(8)));
typedef short bf16x4 __attribute__((ext_vector_type(4)));
constexpr int NWAVES = 8, NTHR = 512;
constexpr int BATCH = 16, SEQ = 4096, T = BATCH * SEQ, D = 1024, FF = 4096, PLE = 256, NIN = 5640, NPROJ = 5632, HGW = 512, NHF = 8;
constexpr float LN_EPS = 1e-5f, RMS_EPS = 1e-6f, ALPHA = 1.189207115002721f, LOG2E = 1.4426950408889634f;
constexpr size_t MiB = 1u << 20, UNIT = 64 * MiB;
constexpr size_t WS_CTL = 0;
constexpr size_t WS_LF = 1 * MiB;
constexpr size_t WS_C2 = 3 * MiB;
constexpr size_t WS_WIN = 6 * MiB;
constexpr size_t WS_WA = 17 * MiB, WS_WB = 18 * MiB, WS_WO = 19 * MiB, WS_WPG = 21 * MiB, WS_WP = 23 * MiB;
constexpr size_t WS_WFF1 = 24 * MiB, WS_WFF2 = 32 * MiB;
constexpr size_t WS_H = 1 * UNIT;
constexpr size_t WS_PROJ = 3 * UNIT;
constexpr size_t WS_YA = 14 * UNIT;
constexpr size_t WS_PB = 15 * UNIT;
constexpr size_t WS_TMP = 3 * UNIT, WS_MERGED = 5 * UNIT;
constexpr size_t WS_FF1 = 3 * UNIT;
constexpr size_t WS_PE = 11 * UNIT;
constexpr size_t WS_END = 16 * UNIT;
constexpr int RING_BYTES = 131072, MISC_OFF = RING_BYTES, LDS_BYTES = 147456;

struct Args { const float* in[19]; float* out; unsigned char* ws; };

__device__ __forceinline__ unsigned f2bf(float f) { unsigned u = __builtin_bit_cast(unsigned, f); return (u + 0x7fffu + ((u >> 16) & 1u)) >> 16; }
__device__ __forceinline__ unsigned pk2(float lo, float hi) { return f2bf(lo) | (f2bf(hi) << 16); }
__device__ __forceinline__ float bf2f(unsigned short h) { return __uint_as_float((unsigned)h << 16); }
__device__ __forceinline__ float wave_sum(float v) {
#pragma unroll
    for (int o = 1; o < 64; o <<= 1) v += __shfl_xor(v, o);
    return v;
}
__device__ __forceinline__ void p0_transpose_item(const float* W, int K, int ldw, int nblk, bf16* WT, LAS float* scr, int item, int lane, int split, int shift) {
    const int kb = item / nblk, nb = item % nblk, k0 = 64 * kb, n0 = 32 * nb; const int s0 = n0 + (n0 >= split ? shift : 0);
#pragma unroll 8
    for (int i = 0; i < 32; ++i) { const int kk = 2 * i + (lane >> 5); scr[kk * 33 + (lane & 31)] = W[(size_t)(k0 + kk) * ldw + s0 + (lane & 31)]; }
    asm volatile("s_waitcnt lgkmcnt(0)" ::: "memory");
    const int c = lane & 7;
#pragma unroll
    for (int j = 0; j < 4; ++j) { const int n = (lane >> 3) + 8 * j; const LAS float* s = scr + (8 * c) * 33 + n;
        v4u o; o.x = pk2(s[0 * 33], s[1 * 33]); o.y = pk2(s[2 * 33], s[3 * 33]); o.z = pk2(s[4 * 33], s[5 * 33]); o.w = pk2(s[6 * 33], s[7 * 33]);
        *(v4u*)(WT + (size_t)(n0 + n) * K + k0 + 8 * c) = o; }
    asm volatile("s_waitcnt lgkmcnt(0)" ::: "memory");
}

__device__ __forceinline__ void p0_prologue(const Args& a, LAS unsigned char* lds, int G) {
    int tid_ = threadIdx.x; asm volatile("" : "+v"(tid_)); const int tid = tid_, lane = tid & 63, wave = __builtin_amdgcn_readfirstlane(tid >> 6);
    unsigned char* ws = a.ws;
    if (blockIdx.x == 0 && tid < 64) ((unsigned*)(ws + WS_CTL))[tid] = 0u;
    const int gw = blockIdx.x * NWAVES + wave, NGW = G * NWAVES;
    const float* w_in = a.in[4];
    {
        LAS float* scr = (LAS float*)(lds + wave * 8704);
        constexpr int I_IN = (D / 64) * (NPROJ / 32), I_A = (HGW / 64) * (D / 32), I_O = (D / 64) * (D / 32), I_F1 = (D / 64) * (FF / 32), I_F2 = (FF / 64) * (D / 32), I_P = (PLE / 64) * (D / 32);
        constexpr int NITEMS = I_IN + 2 * I_A + 2 * I_O + I_F1 + I_F2 + I_P;
        for (int it = gw; it < NITEMS; it += NGW) {
            int r = it;
            if (r < I_IN) { p0_transpose_item(w_in, D, NIN, NPROJ / 32, (bf16*)(ws + WS_WIN), scr, r, lane, 3584, 8); continue; } r -= I_IN;
            if (r < I_A) { p0_transpose_item(a.in[8], HGW, D, D / 32, (bf16*)(ws + WS_WA), scr, r, lane, 1 << 30, 0); continue; } r -= I_A;
            if (r < I_A) { p0_transpose_item(a.in[9], HGW, D, D / 32, (bf16*)(ws + WS_WB), scr, r, lane, 1 << 30, 0); continue; } r -= I_A;
            if (r < I_O) { p0_transpose_item(a.in[10], D, D, D / 32, (bf16*)(ws + WS_WO), scr, r, lane, 1 << 30, 0); continue; } r -= I_O;
            if (r < I_O) { p0_transpose_item(a.in[15], D, D, D / 32, (bf16*)(ws + WS_WPG), scr, r, lane, 1 << 30, 0); continue; } r -= I_O;
            if (r < I_F1) { p0_transpose_item(a.in[13], D, FF, FF / 32, (bf16*)(ws + WS_WFF1), scr, r, lane, 1 << 30, 0); continue; } r -= I_F1;
            if (r < I_F2) { p0_transpose_item(a.in[14], FF, D, D / 32, (bf16*)(ws + WS_WFF2), scr, r, lane, 1 << 30, 0); continue; } r -= I_F2;
            p0_transpose_item(a.in[16], PLE, D, D / 32, (bf16*)(ws + WS_WP), scr, r, lane, 1 << 30, 0);
        }
    }
    __syncthreads();
    LAS float* wf = (LAS float*)lds;
    for (int i = tid; i < D * 8; i += NTHR) wf[i] = w_in[(size_t)(i >> 3) * NIN + 3584 + (i & 7)];
    __syncthreads();
    { const float* p = a.in[1]; bf16* pb = (bf16*)(ws + WS_PB);
      for (size_t i = (size_t)blockIdx.x * NTHR + tid; i < (size_t)T * PLE / 8; i += (size_t)G * NTHR) {
          const f32x4 x0 = *(const f32x4*)(p + 8 * i), x1 = *(const f32x4*)(p + 8 * i + 4);
          v4u o; o.x = pk2(x0.x, x0.y); o.y = pk2(x0.z, x0.w); o.z = pk2(x1.x, x1.y); o.w = pk2(x1.z, x1.w); *(v4u*)(pb + 8 * i) = o; } }
    const float* x = a.in[0]; const float* g0 = a.in[2]; const float* b0 = a.in[3]; const float* fb = a.in[7];
    bf16* H = (bf16*)(ws + WS_H); float* LF = (float*)(ws + WS_LF);
    f32x4 gv[4], bv[4];
#pragma unroll
    for (int j = 0; j < 4; ++j) { gv[j] = *(const f32x4*)(g0 + 256 * j + 4 * lane); bv[j] = *(const f32x4*)(b0 + 256 * j + 4 * lane); }
    for (int m = gw; m < T; m += NGW) {
        const f32x4* xr = (const f32x4*)(x + (size_t)m * D) + lane;
        f32x4 v[4]; float s = 0.f;
#pragma unroll
        for (int j = 0; j < 4; ++j) { v[j] = xr[64 * j]; s += (v[j].x + v[j].y) + (v[j].z + v[j].w); }
        const float mean = wave_sum(s) * (1.f / D); float s2 = 0.f;
#pragma unroll
        for (int j = 0; j < 4; ++j) { v[j] = v[j] - mean; s2 += (v[j].x * v[j].x + v[j].y * v[j].y) + (v[j].z * v[j].z + v[j].w * v[j].w); }
        const float rstd = 1.f / sqrtf(wave_sum(s2) * (1.f / D) + LN_EPS);
        unsigned long long* o8 = (unsigned long long*)(H + (size_t)m * D) + lane;
        float fa[8] = {0.f, 0.f, 0.f, 0.f, 0.f, 0.f, 0.f, 0.f};
#pragma unroll
        for (int j = 0; j < 4; ++j) {
            v[j] = v[j] * rstd * gv[j] + bv[j];
            o8[64 * j] = (unsigned long long)pk2(v[j].x, v[j].y) | ((unsigned long long)pk2(v[j].z, v[j].w) << 32);
#pragma unroll
            for (int e = 0; e < 4; ++e) { const LAS f32x4* wp = (const LAS f32x4*)(wf + (256 * j + 4 * lane + e) * 8); const f32x4 w0 = wp[0], w1 = wp[1]; const float hv = v[j][e];
                fa[0] += hv * w0.x; fa[1] += hv * w0.y; fa[2] += hv * w0.z; fa[3] += hv * w0.w; fa[4] += hv * w1.x; fa[5] += hv * w1.y; fa[6] += hv * w1.z; fa[7] += hv * w1.w; }
        }
        float mine = 0.f;
#pragma unroll
        for (int e = 0; e < 8; ++e) { const float t = wave_sum(fa[e]); if (lane == e) mine = t; }
        if (lane < 8) { const float uu = mine + fb[lane]; const float ls = fminf(uu, 0.f) - log1pf(expf(-fabsf(uu))); LF[(size_t)m * 8 + lane] = ls; }
    }
}
__device__ __forceinline__ void fox_cumsum(const Args& a, LAS unsigned char* lds_misc, int item) {
    int tid_ = threadIdx.x; asm volatile("" : "+v"(tid_)); const int tid = tid_, lane = tid & 63, wave = tid >> 6;
    const int b = item >> 3, hd = item & 7;
    const float* LF = (const float*)(a.ws + WS_LF) + (size_t)b * SEQ * 8 + hd; float* C2 = (float*)(a.ws + WS_C2) + (size_t)item * SEQ;
    float v[8]; float run = 0.f;
#pragma unroll
    for (int i = 0; i < 8; ++i) { run += LF[(size_t)(tid * 8 + i) * 8]; v[i] = run; }
    float inc = run;
#pragma unroll
    for (int o = 1; o < 64; o <<= 1) { const float t = __shfl_up(inc, o); if (lane >= o) inc += t; }
    LAS float* wt = (LAS float*)lds_misc;
    if (lane == 63) wt[wave] = inc;
    __syncthreads();
    float pre = inc - run;
    for (int w = 0; w < wave; ++w) pre += wt[w];
#pragma unroll
    for (int i = 0; i < 8; ++i) C2[tid * 8 + i] = (pre + v[i]) * LOG2E;
    __syncthreads();
}
template <bool TO_BF16> __device__ __forceinline__ void ln_pass(const float* src, const float* gam, const float* bet, bf16* ob, float* of, int G) {
    int tid_ = threadIdx.x; asm volatile("" : "+v"(tid_)); const int tid = tid_, lane = tid & 63, wave = __builtin_amdgcn_readfirstlane(tid >> 6);
    const int gw = blockIdx.x * NWAVES + wave, NGW = G * NWAVES;
    f32x4 gv[4], bv[4];
#pragma unroll
    for (int j = 0; j < 4; ++j) { gv[j] = *(const f32x4*)(gam + 256 * j + 4 * lane); bv[j] = *(const f32x4*)(bet + 256 * j + 4 * lane); }
    for (int m = gw; m < T; m += NGW) {
        const f32x4* xr = (const f32x4*)(src + (size_t)m * D) + lane;
        f32x4 v[4]; float s = 0.f;
#pragma unroll
        for (int j = 0; j < 4; ++j) { v[j] = xr[64 * j]; s += (v[j].x + v[j].y) + (v[j].z + v[j].w); }
        const float mean = wave_sum(s) * (1.f / D); float s2 = 0.f;
#pragma unroll
        for (int j = 0; j < 4; ++j) { v[j] = v[j] - mean; s2 += (v[j].x * v[j].x + v[j].y * v[j].y) + (v[j].z * v[j].z + v[j].w * v[j].w); }
        const float rstd = 1.f / sqrtf(wave_sum(s2) * (1.f / D) + LN_EPS);
#pragma unroll
        for (int j = 0; j < 4; ++j) {
            v[j] = v[j] * rstd * gv[j] + bv[j];
            if (TO_BF16) ((unsigned long long*)(ob + (size_t)m * D) + lane)[64 * j] = (unsigned long long)pk2(v[j].x, v[j].y) | ((unsigned long long)pk2(v[j].z, v[j].w) << 32);
            else ((f32x4*)(of + (size_t)m * D) + lane)[64 * j] = v[j];
        }
    }
}
constexpr int HG_C = 32, HG_QP = 0, HG_KP = 8704, HG_KPT = 17408, HG_VT = 27648, HG_PART = 37888, HG_DEC = 39936, HG_SSQ = 40448, HG_LDS = 41472;
static_assert(HG_LDS <= RING_BYTES, "hgrn2 lds");
__device__ __forceinline__ bf16x8 cat44(bf16x4 a, bf16x4 b) { return (bf16x8){a[0], a[1], a[2], a[3], b[0], b[1], b[2], b[3]}; }
__device__ __forceinline__ bf16x8 pack8f(f32x4 a, f32x4 b) { v4u p; p.x = pk2(a[0], a[1]); p.y = pk2(a[2], a[3]); p.z = pk2(b[0], b[1]); p.w = pk2(b[2], b[3]); return __builtin_bit_cast(bf16x8, p); }
#define MFMA16(a, b, c) __builtin_amdgcn_mfma_f32_16x16x32_bf16((a), (b), (c), 0, 0, 0)
__device__ __forceinline__ void hgrn2_run(LAS unsigned char* lds, int b, int h, const bf16* QH, const bf16* GL, const bf16* VH, const bf16* GT, const float* norm_g, bf16* YA) {
    int tid_ = threadIdx.x; asm volatile("" : "+v"(tid_)); const int tid = tid_, lane = tid & 63, w = __builtin_amdgcn_readfirstlane(tid >> 6), i16 = lane & 15, g4 = lane >> 4;
    const int k = tid & 127, tq = tid >> 7;
    LAS unsigned short* Qp = (LAS unsigned short*)(lds + HG_QP);
    LAS unsigned short* Kp = (LAS unsigned short*)(lds + HG_KP);
    LAS unsigned short* KpT = (LAS unsigned short*)(lds + HG_KPT);
    LAS unsigned short* VT = (LAS unsigned short*)(lds + HG_VT);
    LAS float* part = (LAS float*)(lds + HG_PART);
    LAS float* dec = (LAS float*)(lds + HG_DEC);
    LAS float* ssq = (LAS float*)(lds + HG_SSQ);
    const size_t rowbase = (size_t)b * SEQ; const int colbase = h * 128;
    const int n = 16 * w + i16;
    const float ng = norm_g[colbase + n];
    f32x4 S[8];
#pragma unroll
    for (int i = 0; i < 8; ++i) S[i] = (f32x4){0.f, 0.f, 0.f, 0.f};
    unsigned short gr[8], qr[8], vr[8], tr[8];
#pragma unroll
    for (int i = 0; i < 8; ++i) { const size_t o = (rowbase + 8 * tq + i) * HGW + colbase + k; gr[i] = GL[o]; qr[i] = QH[o]; vr[i] = VH[o]; }
#pragma unroll
    for (int i = 0; i < 8; ++i) { const int t = 16 * (i >> 2) + 4 * g4 + (i & 3); tr[i] = GT[(rowbase + t) * HGW + colbase + n]; }
    for (int c = 0; c < SEQ / HG_C; ++c) {
        const int t0 = c * HG_C;
        const int t1 = (c + 1 < SEQ / HG_C) ? t0 + HG_C : t0;
        unsigned short gr2[8], qr2[8], vr2[8], tr2[8];
#pragma unroll
        for (int i = 0; i < 8; ++i) { const size_t o = (rowbase + t1 + 8 * tq + i) * HGW + colbase + k; gr2[i] = GL[o]; qr2[i] = QH[o]; vr2[i] = VH[o]; }
#pragma unroll
        for (int i = 0; i < 8; ++i) { const int t = 16 * (i >> 2) + 4 * g4 + (i & 3); tr2[i] = GT[(rowbase + t1 + t) * HGW + colbase + n]; }
        float gl[8], bc[8]; float run = 0.f;
#pragma unroll
        for (int i = 0; i < 8; ++i) { gl[i] = bf2f(gr[i]); run += gl[i]; bc[i] = run; }
        part[tq * 128 + k] = run;
        __syncthreads();
        const float p0 = part[k], p1 = part[128 + k], p2 = part[256 + k], p3 = part[384 + k];
        const float pre = (tq > 0 ? p0 : 0.f) + (tq > 1 ? p1 : 0.f) + (tq > 2 ? p2 : 0.f);
        unsigned short kp[8];
#pragma unroll
        for (int i = 0; i < 8; ++i) {
            const float bt = pre + bc[i]; const int t = 8 * tq + i;
            Qp[t * 136 + k] = (unsigned short)f2bf(bf2f(qr[i]) * __expf(bt));
            const float kk = (1.0f - __expf(gl[i])) * __expf(fminf(-bt, 80.f));
            kp[i] = (unsigned short)f2bf(kk); Kp[t * 136 + k] = kp[i];
        }
        { v4u o; o.x = kp[0] | ((unsigned)kp[1] << 16); o.y = kp[2] | ((unsigned)kp[3] << 16); o.z = kp[4] | ((unsigned)kp[5] << 16); o.w = kp[6] | ((unsigned)kp[7] << 16);
          *(LAS v4u*)(KpT + k * 40 + 8 * tq) = o;
          v4u q; q.x = vr[0] | ((unsigned)vr[1] << 16); q.y = vr[2] | ((unsigned)vr[3] << 16); q.z = vr[4] | ((unsigned)vr[5] << 16); q.w = vr[6] | ((unsigned)vr[7] << 16);
          *(LAS v4u*)(VT + k * 40 + 8 * tq) = q; }
        if (tq == 3) dec[k] = __expf(((p0 + p1) + (p2 + p3)));
        __syncthreads();
        f32x4 sc00 = {0.f, 0.f, 0.f, 0.f}, sc01 = sc00, sc11 = sc00;
#pragma unroll
        for (int kk = 0; kk < 4; ++kk) {
            const bf16x8 a0 = *(const LAS bf16x8*)(Kp + i16 * 136 + 32 * kk + 8 * g4), a1 = *(const LAS bf16x8*)(Kp + (16 + i16) * 136 + 32 * kk + 8 * g4);
            const bf16x8 b0 = *(const LAS bf16x8*)(Qp + i16 * 136 + 32 * kk + 8 * g4), b1 = *(const LAS bf16x8*)(Qp + (16 + i16) * 136 + 32 * kk + 8 * g4);
            sc00 = MFMA16(a0, b0, sc00); sc01 = MFMA16(a0, b1, sc01); sc11 = MFMA16(a1, b1, sc11);
        }
#pragma unroll
        for (int r = 0; r < 4; ++r) { const bool keep = (4 * g4 + r) <= i16; sc00[r] = keep ? sc00[r] : 0.f; sc11[r] = keep ? sc11[r] : 0.f; }
        const bf16x8 pa0 = pack8f(sc00, (f32x4){0.f, 0.f, 0.f, 0.f}), pa1 = pack8f(sc01, sc11);
        f32x4 o0 = {0.f, 0.f, 0.f, 0.f}, o1 = o0;
#pragma unroll
        for (int kk = 0; kk < 4; ++kk) {
            const bf16x8 Sb = pack8f(S[2 * kk], S[2 * kk + 1]);
            const bf16x8 qa0 = cat44(*(const LAS bf16x4*)(Qp + i16 * 136 + 32 * kk + 4 * g4), *(const LAS bf16x4*)(Qp + i16 * 136 + 32 * kk + 16 + 4 * g4));
            const bf16x8 qa1 = cat44(*(const LAS bf16x4*)(Qp + (16 + i16) * 136 + 32 * kk + 4 * g4), *(const LAS bf16x4*)(Qp + (16 + i16) * 136 + 32 * kk + 16 + 4 * g4));
            o0 = MFMA16(qa0, Sb, o0); o1 = MFMA16(qa1, Sb, o1);
        }
        { const bf16x8 vb = cat44(*(const LAS bf16x4*)(VT + n * 40 + 4 * g4), *(const LAS bf16x4*)(VT + n * 40 + 16 + 4 * g4));
          o0 = MFMA16(pa0, vb, o0); o1 = MFMA16(pa1, vb, o1); }
        { const bf16x8 vn = *(const LAS bf16x8*)(VT + n * 40 + 8 * g4);
#pragma unroll
          for (int tt = 0; tt < 8; ++tt) { const bf16x8 ka = *(const LAS bf16x8*)(KpT + (16 * tt + i16) * 40 + 8 * g4); S[tt] = MFMA16(ka, vn, S[tt]);
              const f32x4 dv = *(const LAS f32x4*)(dec + 16 * tt + 4 * g4); S[tt] = S[tt] * dv; } }
        f32x4 q0 = o0 * o0, q1 = o1 * o1;
#pragma unroll
        for (int off = 1; off < 16; off <<= 1) {
#pragma unroll
            for (int r = 0; r < 4; ++r) { q0[r] += __shfl_xor(q0[r], off); q1[r] += __shfl_xor(q1[r], off); } }
        if (i16 == 0) { *(LAS f32x4*)(ssq + w * 32 + 4 * g4) = q0; *(LAS f32x4*)(ssq + w * 32 + 16 + 4 * g4) = q1; }
        __syncthreads();
        f32x4 s0 = {0.f, 0.f, 0.f, 0.f}, s1 = s0;
#pragma unroll
        for (int ww = 0; ww < 8; ++ww) { s0 += *(const LAS f32x4*)(ssq + ww * 32 + 4 * g4); s1 += *(const LAS f32x4*)(ssq + ww * 32 + 16 + 4 * g4); }
#pragma unroll
        for (int r = 0; r < 4; ++r) {
            const float y0 = o0[r] * __builtin_amdgcn_rsqf(s0[r] * (1.0f / 128.0f) + RMS_EPS) * ng * bf2f(tr[r]);
            const float y1 = o1[r] * __builtin_amdgcn_rsqf(s1[r] * (1.0f / 128.0f) + RMS_EPS) * ng * bf2f(tr[4 + r]);
            YA[(rowbase + t0 + 4 * g4 + r) * HGW + colbase + n] = (unsigned short)f2bf(y0);
            YA[(rowbase + t0 + 16 + 4 * g4 + r) * HGW + colbase + n] = (unsigned short)f2bf(y1);
        }
#pragma unroll
        for (int i = 0; i < 8; ++i) { gr[i] = gr2[i]; qr[i] = qr2[i]; vr[i] = vr2[i]; tr[i] = tr2[i]; }
    }
    __syncthreads();
}
#ifndef PH_MASK
#define PH_MASK 0xfff
#endif
#define PH(k) if constexpr ((PH_MASK >> (k)) & 1)
__device__ unsigned g_bar_word[64];
__device__ __forceinline__ void grid_barrier(unsigned G) {
    asm volatile("s_waitcnt vmcnt(0)" ::: "memory");
    __syncthreads();
    if (threadIdx.x == 0) {
        __builtin_amdgcn_fence(__ATOMIC_RELEASE, "agent");
        asm volatile("s_waitcnt vmcnt(0)" ::: "memory");
        const unsigned old = __hip_atomic_fetch_add(&g_bar_word[0], 1u, __ATOMIC_RELAXED, __HIP_MEMORY_SCOPE_AGENT);
        const unsigned target = (old / G + 1u) * G;
        while ((int)(__hip_atomic_load(&g_bar_word[0], __ATOMIC_RELAXED, __HIP_MEMORY_SCOPE_AGENT) - target) < 0) __builtin_amdgcn_s_sleep(2);
    }
    __syncthreads();
    __builtin_amdgcn_fence(__ATOMIC_ACQUIRE, "agent");
    asm volatile("s_waitcnt vmcnt(0)" ::: "memory");
}
#ifndef P1_REPS
#define P1_REPS 1
#endif
#ifndef DBG_STAGE
#define DBG_STAGE 0
#define PG8_STRICT_NOTE 1
#endif
__device__ __forceinline__ void dbg_copy(const bf16* src, float* out, int G) {
    for (size_t i = (size_t)blockIdx.x * NTHR + threadIdx.x; i < (size_t)T * D / 8; i += (size_t)G * NTHR) {
        const v4u w = *(const v4u*)(src + 8 * i);
        f32x4 a = {bf2f(w.x & 0xffff), bf2f(w.x >> 16), bf2f(w.y & 0xffff), bf2f(w.y >> 16)}, b = {bf2f(w.z & 0xffff), bf2f(w.z >> 16), bf2f(w.w & 0xffff), bf2f(w.w >> 16)};
        *(f32x4*)(out + 8 * i) = a; *(f32x4*)(out + 8 * i + 4) = b; }
}
#define DBG(k, src) do { if constexpr (DBG_STAGE == (k)) { GRID_SYNC(); dbg_copy((const bf16*)(src), args.out, G); return; } } while (0)
#define GRID_SYNC() grid_barrier((unsigned)G)
__global__ void __launch_bounds__(NTHR, 2) fwd_mega(Args args) {
    extern __shared__ __attribute__((aligned(16))) unsigned char lds_raw[];
    cg::grid_group grid = cg::this_grid();
    LAS unsigned char* lds = (LAS unsigned char*)lds_raw;
    const int tid = threadIdx.x; const int G = gridDim.x;
    unsigned char* ws = args.ws;
#ifndef NONCOOP_TEST
    grid.sync();
#endif
    bf16* H = (bf16*)(ws + WS_H);
    bf16* PROJ = (bf16*)(ws + WS_PROJ);
    bf16 *QH = PROJ, *GLF = PROJ + UNIT / 2, *VHB = PROJ + 2 * (UNIT / 2), *GTB = PROJ + 3 * (UNIT / 2), *FQ = PROJ + 4 * (UNIT / 2), *FK = PROJ + 5 * (UNIT / 2), *FV = PROJ + 6 * (UNIT / 2);
    bf16 *GA = PROJ + 7 * (UNIT / 2), *GB = PROJ + 9 * (UNIT / 2);
    bf16* YA = (bf16*)(ws + WS_YA);

    PH(0) p0_prologue(args, lds, G);
    GRID_SYNC();

    DBG(1, H);
#ifdef DELAY_TEST
    { const unsigned long long t0 = __builtin_amdgcn_s_memrealtime(); while (__builtin_amdgcn_s_memrealtime() - t0 < 30000ull) __builtin_amdgcn_s_sleep(8); GRID_SYNC(); }
#endif
    PH(1) for (int it = blockIdx.x; it < BATCH * NHF; it += G) fox_cumsum(args, lds + MISC_OFF, it);
    for (int rep_ = 0; rep_ < P1_REPS; ++rep_) { if (rep_) GRID_SYNC();
    PH(2) {
        pg8::Gemm g{H, (const bf16*)(ws + WS_WIN), T, NPROJ, D}; pg8::StaticOrder S; S.init(T, NPROJ, G, (int)blockIdx.x);
        pg8::EpiProj E{PROJ, args.in[5]};
#ifdef P1_TRIVIAL
        (void)g; (void)S; (void)E;
        for (size_t i = (size_t)blockIdx.x * NTHR + threadIdx.x; i < (size_t)T * D / 8; i += (size_t)G * NTHR) { const v4u w = *(const v4u*)(H + 8 * i); v4u o; o.x = w.x ^ 0x80008000u; o.y = w.y; o.z = w.z ^ 0x80000000u; o.w = w.w; *(v4u*)(GA + 8 * i) = o; }
#else
        pg8::gemm_phase<pg8::EpiProj, pg8::StaticOrder, true, true>(lds, g, S, E);
#endif
    }
    }
    GRID_SYNC();

    DBG(2, GA);
    PH(3) for (int it = blockIdx.x; it < BATCH * 4; it += G) hgrn2_run(lds, it >> 2, it & 3, QH, GLF, VHB, GTB, args.in[6], YA);
    PH(4) {
        unsigned* ctr = (unsigned*)(ws + WS_CTL);
        volatile LAS unsigned* ub = (volatile LAS unsigned*)(lds + MISC_OFF + 64);
        const float* C2 = (const float*)(ws + WS_C2);
        for (;;) {
            if (tid == 0) ub[0] = atomicAdd(ctr, 1u);
            __syncthreads();
            const unsigned u = ub[0];
            __syncthreads();
            if (u >= (unsigned)(BATCH * NHF * 16)) break;
            const int qb = 15 - (int)(u >> 7), ix = (int)(u & 127), bh = ((ix & 15) << 3) | (7 - (ix >> 4));
            attn_body::attn_unit<8>(bh >> 3, bh & 7, qb, (const attn_body::bf16*)FQ, (const attn_body::bf16*)FK, (const attn_body::bf16*)FV, (attn_body::bf16*)FQ, C2 + (size_t)bh * SEQ, (char*)lds_raw);
        }
    }
    GRID_SYNC();

    PH(5) {
        bf16* TMP = (bf16*)(ws + WS_TMP); bf16* MG = (bf16*)(ws + WS_MERGED);
        pg8::StaticOrder S; S.init(T, D, G, (int)blockIdx.x);
        { pg8::Gemm g{YA, (const bf16*)(ws + WS_WA), T, D, HGW}; pg8::EpiGate E{TMP, GA, nullptr}; pg8::gemm_phase<pg8::EpiGate, pg8::StaticOrder, true, true>(lds, g, S, E); }
        { pg8::Gemm g{FQ, (const bf16*)(ws + WS_WB), T, D, HGW}; pg8::EpiGate E{MG, GB, TMP}; pg8::gemm_phase<pg8::EpiGate, pg8::StaticOrder, true, true>(lds, g, S, E); }
    }
    GRID_SYNC();
    DBG(3, ws + WS_MERGED);
    PH(6) {
        pg8::StaticOrder S; S.init(T, D, G, (int)blockIdx.x);
        pg8::Gemm g{(const bf16*)(ws + WS_MERGED), (const bf16*)(ws + WS_WO), T, D, D}; pg8::EpiRes<0> E{args.out, H, ALPHA};
        pg8::gemm_phase<pg8::EpiRes<0>, pg8::StaticOrder, true, true>(lds, g, S, E);
    }
    GRID_SYNC();
    PH(7) ln_pass<true>(args.out, args.in[11], args.in[12], H, nullptr, G);
    GRID_SYNC();
    DBG(5, H);
    PH(8) {
        { pg8::StaticOrder S; S.init(T, FF, G, (int)blockIdx.x); pg8::Gemm g{H, (const bf16*)(ws + WS_WFF1), T, FF, D}; pg8::EpiAct<1> E{(bf16*)(ws + WS_FF1), FF};
          pg8::gemm_phase<pg8::EpiAct<1>, pg8::StaticOrder, true, true>(lds, g, S, E); }
        { pg8::StaticOrder S; S.init(T, D, G, (int)blockIdx.x); pg8::Gemm g{(const bf16*)(ws + WS_PB), (const bf16*)(ws + WS_WP), T, D, PLE}; pg8::EpiAct<0> E{(bf16*)(ws + WS_PE), D};
          pg8::gemm_phase<pg8::EpiAct<0>, pg8::StaticOrder, true, true>(lds, g, S, E); }
    }
    GRID_SYNC();
    DBG(6, ws + WS_PE);
    PH(9) {
        pg8::StaticOrder S; S.init(T, D, G, (int)blockIdx.x);
        { pg8::Gemm g{(const bf16*)(ws + WS_FF1), (const bf16*)(ws + WS_WFF2), T, D, FF}; pg8::EpiRes<0> E{args.out, H, ALPHA}; pg8::gemm_phase<pg8::EpiRes<0>, pg8::StaticOrder, true, true>(lds, g, S, E); }
        { pg8::Gemm g{H, (const bf16*)(ws + WS_WPG), T, D, D}; pg8::EpiRes<1> E{args.out, (const bf16*)(ws + WS_PE), 0.f}; pg8::gemm_phase<pg8::EpiRes<1>, pg8::StaticOrder, true, true>(lds, g, S, E); }
    }
    GRID_SYNC();
    PH(10) ln_pass<false>(args.out, args.in[17], args.in[18], nullptr, args.out, G);
}

extern "C" void kernel_launch(void* const* d_in, const int* in_sizes, int n_in, void* d_out, int out_size, void* d_ws, size_t ws_size, hipStream_t stream) {
    static int grid = 0;
    if (grid == 0) {
        if (n_in != 19 || ws_size < WS_END) { fprintf(stderr, "kernel_launch: unexpected n_in %d / ws %zu\n", n_in, ws_size); grid = -1; return; }
        int dev = 0, cus = 0, per_cu = 0;
        (void)hipGetDevice(&dev); (void)hipDeviceGetAttribute(&cus, hipDeviceAttributeMultiprocessorCount, dev);
        if (hipFuncSetAttribute((const void*)fwd_mega, hipFuncAttributeMaxDynamicSharedMemorySize, LDS_BYTES) != hipSuccess) { fprintf(stderr, "kernel_launch: hipFuncSetAttribute failed\n"); }
        if (hipOccupancyMaxActiveBlocksPerMultiprocessor(&per_cu, (const void*)fwd_mega, NTHR, LDS_BYTES) != hipSuccess || per_cu < 1) { fprintf(stderr, "kernel_launch: occupancy query says %d\n", per_cu); per_cu = 1; }
        (void)hipGetLastError();
        grid = cus * 1;
        if (grid <= 0) grid = 256;
    }
    if (grid < 0) return;
    Args a{};
    for (int i = 0; i < 19; ++i) a.in[i] = (const float*)d_in[i];
    a.out = (float*)d_out; a.ws = (unsigned char*)d_ws;
    void* kargs[] = {&a};
#ifdef NONCOOP_TEST
    hipLaunchKernelGGL(fwd_mega, dim3(grid), dim3(NTHR), LDS_BYTES, stream, a); hipError_t e = hipPeekAtLastError(); (void)kargs;
#else
    hipError_t e = hipLaunchCooperativeKernel((const void*)fwd_mega, dim3(grid), dim3(NTHR), kargs, LDS_BYTES, stream);
#endif
    if (e != hipSuccess) fprintf(stderr, "cooperative launch failed: %s (grid %d)\n", hipGetErrorString(e), grid);
}
```

```cpp
#include <hip/hip_runtime.h>
#include <hip/hip_cooperative_groups.h>
#include <cstdio>
#include <cstdint>
namespace cg = cooperative_groups;
#define PG8_AUX 0
#define PROBE_ACT 4
namespace pg8 {
#define PG8_LAS __attribute__((address_space(3)))
typedef unsigned short bf16_t;
typedef short bf16x8 __attribute__((ext_vector_type(8)));
typedef float f32x4 __attribute__((ext_vector_type(4)));
typedef unsigned u32x4 __attribute__((ext_vector_type(4)));
constexpr int BM = 256, BK = 64, HALF = 128, HTB = HALF * BK * 2  , STAGE_BYTES = 8 * HTB, NXCD = 8, WGM = 8;

__host__ __device__ __forceinline__ int lds_byte(int r, int c) { const int st = (r >> 4) * 2 + (c >> 5), rr = r & 15, cc = c & 31, ob = rr * 64 + cc * 2; return st * 1024 + (ob ^ (((ob >> 9) & 1) << 5)); }
__host__ __device__ __forceinline__ void stage_rc(int b, int& R, int& C) { const int st = b / 1024, sb = b % 1024, swz = sb ^ (((sb >> 9) & 1) << 5); R = (st >> 1) * 16 + swz / 64; C = (st & 1) * 32 + (swz % 64) / 2; }
__host__ __device__ __forceinline__ int perm32(int rho) { const int n = rho >> 4, i = rho & 15; return 8 * (i >> 2) + 4 * n + (i & 3); }

struct Unit { int pm, pn; };
struct Gemm { const bf16_t* A; const bf16_t* Bt; int M, N, K; };

struct StaticOrder {
    int nM, nN, nwg, G, c;
    __host__ __device__ void init(int M, int N, int G_, int c_) { nM = M / BM; nN = N / BM; nwg = nM * nN; G = G_; c = c_; }
    __host__ __device__ bool next(int i, Unit& u) const {
        const long L = (long)i * G + c; if (L >= nwg) return false;
        int wgid = (int)L; { const int q = nwg / NXCD, r = nwg % NXCD, xcd = wgid % NXCD, off = wgid / NXCD; wgid = (xcd < r ? xcd * (q + 1) : r * (q + 1) + (xcd - r) * q) + off; }
        const int nig = WGM * nN, gid = wgid / nig, fm = gid * WGM, gsz = (nM - fm) < WGM ? (nM - fm) : WGM;
        u.pm = fm + ((wgid % nig) % gsz); u.pn = (wgid % nig) / gsz; return true;
    }
    __device__ __forceinline__ void a_ready(const Unit&) const {}
    __device__ __forceinline__ void done(const Unit&) const {}
};

typedef float f32x2_t __attribute__((ext_vector_type(2))); typedef __bf16 bf16x2_t __attribute__((ext_vector_type(2)));
__device__ __forceinline__ unsigned cvt_pk_bf16(float lo, float hi) { f32x2_t v = {lo, hi}; bf16x2_t b = __builtin_convertvector(v, bf16x2_t); return __builtin_bit_cast(unsigned, b); }
__device__ __forceinline__ float sigmoidf_(float x) { return __builtin_amdgcn_rcpf(1.0f + __expf(-x)); }
__device__ __forceinline__ float bflo(unsigned w) { return __uint_as_float(w << 16); }
__device__ __forceinline__ float bfhi(unsigned w) { return __uint_as_float(w & 0xffff0000u); }
#define PG8_TILE_BEGIN \
    _Pragma("unroll") for (int ai = 0; ai < 2; ++ai) _Pragma("unroll") for (int m = 0; m < 4; ++m) _Pragma("unroll") for (int bj = 0; bj < 2; ++bj) { \
        const int row = u.pm * BM + ai * HALF + wr * 64 + m * 16 + fr; const int ct = bj * HALF + wc * 32 + 8 * fq; f32x4 v0 = acc[ai][bj][m][0], v1 = acc[ai][bj][m][1];
#define PG8_TILE_END }
#define PG8_EPI_IDS int l_ = threadIdx.x; asm volatile("" : "+v"(l_)); const int fr = l_ & 15, fq = (l_ >> 4) & 3; const int wv_ = __builtin_amdgcn_readfirstlane(l_ >> 6), wr = wv_ >> 2, wc = wv_ & 3;

constexpr size_t UNIT_ELEMS = (size_t)65536 * 512;
constexpr float ATT_C2 = 0.125f * 1.4426950408889634f;
struct EpiProj {
    static constexpr bool PERM = true, AFTER_DRAIN = false;
    bf16_t* base;
    const float* hg_lb;
    template <int ACT> __device__ __forceinline__ void tile(const f32x4 (&acc)[2][2][4][2], const Unit& u, int wr, int wc, int fr, int fq, bf16_t* O, int ldc, int colt, int lbcol) const {
        float lb[2][8];
        if (ACT == 1) {
#pragma unroll
            for (int bj = 0; bj < 2; ++bj)
#pragma unroll
                for (int i = 0; i < 8; ++i) { const int c = lbcol + bj * HALF + wc * 32 + 8 * fq + i; lb[bj][i] = sigmoidf_(hg_lb[c] - hg_lb[512 + c]); }
        }
        PG8_TILE_BEGIN {
            float x[8] = {v0[0], v0[1], v0[2], v0[3], v1[0], v1[1], v1[2], v1[3]};
#pragma unroll
            for (int i = 0; i < 8; ++i) {
                if (ACT == 0) x[i] = x[i] * sigmoidf_(x[i]);
                else if (ACT == 1) { const float l = lb[bj][i]; x[i] = __logf(l + (1.0f - l) * sigmoidf_(x[i])); }
                else if (ACT == 3) x[i] = x[i] * ATT_C2;
                else if (ACT == 4) x[i] = sigmoidf_(x[i]);
            }
            u32x4 w; w.x = cvt_pk_bf16(x[0], x[1]); w.y = cvt_pk_bf16(x[2], x[3]); w.z = cvt_pk_bf16(x[4], x[5]); w.w = cvt_pk_bf16(x[6], x[7]);
            *(u32x4*)(O + (size_t)row * ldc + colt + ct) = w;
        } PG8_TILE_END
    }
    __device__ __forceinline__ void operator()(const f32x4 (&acc)[2][2][4][2], const Unit& u, int, int, int, int) const {
        PG8_EPI_IDS
        const int pn = u.pn;
        if (pn < 14) { const int g = pn >> 1; bf16_t* O = base + (size_t)g * UNIT_ELEMS; const int colt = (pn & 1) * 256;
            if (g == 0 || g == 3) tile<0>(acc, u, wr, wc, fr, fq, O, 512, colt, 0);
            else if (g == 1) tile<1>(acc, u, wr, wc, fr, fq, O, 512, colt, colt);
            else if (g == 4) tile<3>(acc, u, wr, wc, fr, fq, O, 512, colt, 0);
            else tile<2>(acc, u, wr, wc, fr, fq, O, 512, colt, 0);
        } else { const int g = (pn - 14) >> 2; bf16_t* O = base + (size_t)(7 + 2 * g) * UNIT_ELEMS; tile<PROBE_ACT>(acc, u, wr, wc, fr, fq, O, 1024, ((pn - 14) & 3) * 256, 0); }
    }
};
template <int ACT> struct EpiAct {
    static constexpr bool PERM = true, AFTER_DRAIN = false;
    bf16_t* O; int ldc;
    __device__ __forceinline__ void operator()(const f32x4 (&acc)[2][2][4][2], const Unit& u, int, int, int, int) const {
        PG8_EPI_IDS
        const int colt = u.pn * BM;
        PG8_TILE_BEGIN {
            if (ACT == 1) { v0 = __builtin_elementwise_max(v0, (f32x4){0.f, 0.f, 0.f, 0.f}); v1 = __builtin_elementwise_max(v1, (f32x4){0.f, 0.f, 0.f, 0.f}); v0 = v0 * v0; v1 = v1 * v1; }
            u32x4 w; w.x = cvt_pk_bf16(v0[0], v0[1]); w.y = cvt_pk_bf16(v0[2], v0[3]); w.z = cvt_pk_bf16(v1[0], v1[1]); w.w = cvt_pk_bf16(v1[2], v1[3]);
            *(u32x4*)(O + (size_t)row * ldc + colt + ct) = w;
        } PG8_TILE_END
    }
};
struct EpiGate {
    static constexpr bool PERM = true, AFTER_DRAIN = false;
    bf16_t* O; const bf16_t* gate; const bf16_t* add;
    __device__ __forceinline__ void operator()(const f32x4 (&acc)[2][2][4][2], const Unit& u, int, int, int, int) const {
        PG8_EPI_IDS
        const int colt = u.pn * BM;
        PG8_TILE_BEGIN {
            const size_t off = (size_t)row * 1024 + colt + ct;
            const u32x4 g = *(const u32x4*)(gate + off);
            float x[8] = {v0[0] * bflo(g.x), v0[1] * bfhi(g.x), v0[2] * bflo(g.y), v0[3] * bfhi(g.y), v1[0] * bflo(g.z), v1[1] * bfhi(g.z), v1[2] * bflo(g.w), v1[3] * bfhi(g.w)};
            if (add) { const u32x4 a = *(const u32x4*)(add + off);
                x[0] += bflo(a.x); x[1] += bfhi(a.x); x[2] += bflo(a.y); x[3] += bfhi(a.y); x[4] += bflo(a.z); x[5] += bfhi(a.z); x[6] += bflo(a.w); x[7] += bfhi(a.w); }
            u32x4 w; w.x = cvt_pk_bf16(x[0], x[1]); w.y = cvt_pk_bf16(x[2], x[3]); w.z = cvt_pk_bf16(x[4], x[5]); w.w = cvt_pk_bf16(x[6], x[7]);
            *(u32x4*)(O + off) = w;
        } PG8_TILE_END
    }
};
template <int MODE> struct EpiRes {
    static constexpr bool PERM = true, AFTER_DRAIN = false;
    float* O; const bf16_t* base; float alpha;
    __device__ __forceinline__ void operator()(const f32x4 (&acc)[2][2][4][2], const Unit& u, int, int, int, int) const {
        PG8_EPI_IDS
        const int colt = u.pn * BM;
        PG8_TILE_BEGIN {
            const size_t off = (size_t)row * 1024 + colt + ct;
            const u32x4 b = *(const u32x4*)(base + off);
            const f32x4 b0 = {bflo(b.x), bfhi(b.x), bflo(b.y), bfhi(b.y)}, b1 = {bflo(b.z), bfhi(b.z), bflo(b.w), bfhi(b.w)};
            f32x4 o0, o1;
            if (MODE == 0) { o0 = b0 * alpha + v0; o1 = b1 * alpha + v1; }
            else { const f32x4 p0 = *(const f32x4*)(O + off), p1 = *(const f32x4*)(O + off + 4);
                f32x4 s0, s1;
#pragma unroll
                for (int i = 0; i < 4; ++i) { s0[i] = sigmoidf_(v0[i]); s1[i] = sigmoidf_(v1[i]); }
                o0 = p0 + s0 * b0; o1 = p1 + s1 * b1; }
            *(f32x4*)(O + off) = o0; *(f32x4*)(O + off + 4) = o1;
        } PG8_TILE_END
    }
};
template <class Epi, class Sched, bool ALIGN_EPI = false, bool SP2 = false>
__device__ __forceinline__ void gemm_phase(PG8_LAS unsigned char* lds, const Gemm g, const Sched& S, const Epi& E) {
    int tid_ = threadIdx.x; asm volatile("" : "+v"(tid_)); const int tid = tid_, wid = __builtin_amdgcn_readfirstlane(tid >> 6), lane = tid & 63, wr = wid >> 2, wc = wid & 3, fr = lane & 15, fq = lane >> 4;
    const int K = g.K, nt = K / BK;
    unsigned voffA[2], voffB[2];
#pragma unroll
    for (int i = 0; i < 2; ++i) { int R, C; stage_rc(tid * 16 + i * 8192, R, C); const int Rb = Epi::PERM ? ((R & ~31) + perm32(R & 31)) : R;
        voffA[i] = (unsigned)(R * K + C) * 2u; voffB[i] = (unsigned)(Rb * K + C) * 2u; }
    const size_t kstep = (size_t)(BK * 2);
    const size_t hstep = (size_t)HALF * K * 2;
    const size_t tstep = 2 * hstep;
    const unsigned ldsw = (unsigned)wid * 1024u;
    const int aoff = lds_byte(wr * 64 + fr, fq * 8), boff = lds_byte(wc * 32 + fr, fq * 8);
#define PG8_SA(b, h) (((b) * 2 + (h)) * HTB)
#define PG8_SB(b, h) ((4 + (b) * 2 + (h)) * HTB)
#define PG8_STAGE(bufoff, gbase, voff) do { _Pragma("unroll") for (int _i = 0; _i < 2; ++_i) \
        __builtin_amdgcn_global_load_lds((const unsigned*)((const char*)(gbase) + (voff)[_i]), (PG8_LAS unsigned*)(lds + (bufoff) + ldsw + _i * 8192), 16, 0, PG8_AUX); } while (0)
#define PG8_LDA(dst, b, h) do { _Pragma("unroll") for (int m = 0; m < 4; ++m) _Pragma("unroll") for (int k = 0; k < 2; ++k) dst[m][k] = *(const PG8_LAS bf16x8*)(lds + PG8_SA(b, h) + aoff + m * 2048 + k * 1024); } while (0)
#define PG8_LDB(dst, b, h) do { _Pragma("unroll") for (int n = 0; n < 2; ++n) _Pragma("unroll") for (int k = 0; k < 2; ++k) dst[n][k] = *(const PG8_LAS bf16x8*)(lds + PG8_SB(b, h) + boff + n * 2048 + k * 1024); } while (0)
#define PG8_MMA(ai, bj, At, Bt) do { __builtin_amdgcn_s_setprio(1); _Pragma("unroll") for (int m = 0; m < 4; ++m) _Pragma("unroll") for (int n = 0; n < 2; ++n) _Pragma("unroll") for (int k = 0; k < 2; ++k) \
        acc[ai][bj][m][n] = __builtin_amdgcn_mfma_f32_16x16x32_bf16(Bt[n][k], At[m][k], acc[ai][bj][m][n], 0, 0, 0); __builtin_amdgcn_s_setprio(0); } while (0)
#ifdef PG8_STRICT
#define PG8_WAIT_V(n) asm volatile("s_waitcnt vmcnt(0)" ::: "memory")
#else
#define PG8_WAIT_V(n) asm volatile("s_waitcnt vmcnt(" #n ")" ::: "memory")
#endif
#define PG8_WAIT_L(n) asm volatile("s_waitcnt lgkmcnt(" #n ")" ::: "memory")
#define PG8_BAR __builtin_amdgcn_s_barrier()
#define PG8_SCHED __builtin_amdgcn_sched_barrier(0)
#ifdef PG8_SIMPLE
    {
        const unsigned lw = ldsw + (unsigned)lane * 16u;
#define PG8_GLD(dst, gbase, voff) do { _Pragma("unroll") for (int _i = 0; _i < 2; ++_i) dst[_i] = *(const u32x4*)((const char*)(gbase) + (voff)[_i]); } while (0)
#define PG8_LST(bufoff, src) do { _Pragma("unroll") for (int _i = 0; _i < 2; ++_i) *(PG8_LAS u32x4*)(lds + (bufoff) + lw + _i * 8192) = src[_i]; } while (0)
        Unit cur_;
        for (int ui_ = 0; S.next(ui_, cur_); ++ui_) {
            f32x4 acc[2][2][4][2];
#pragma unroll
            for (int a = 0; a < 2; ++a)
#pragma unroll
                for (int b = 0; b < 2; ++b)
#pragma unroll
                    for (int m = 0; m < 4; ++m)
#pragma unroll
                        for (int n = 0; n < 2; ++n) acc[a][b][m][n] = (f32x4){0.f, 0.f, 0.f, 0.f};
            bf16x8 At[4][2], B0[2][2], B1[2][2];
            u32x4 rb0[2], rb1[2], ra0[2], ra1[2];
            const char* cA = (const char*)g.A + (size_t)cur_.pm * tstep; const char* cB = (const char*)g.Bt + (size_t)cur_.pn * tstep;
            PG8_GLD(rb0, cB, voffB); PG8_GLD(rb1, cB + hstep, voffB); PG8_GLD(ra0, cA, voffA); PG8_GLD(ra1, cA + hstep, voffA);
            PG8_LST(PG8_SB(0, 0), rb0); PG8_LST(PG8_SB(0, 1), rb1); PG8_LST(PG8_SA(0, 0), ra0); PG8_LST(PG8_SA(0, 1), ra1);
            __syncthreads();
#define PG8_HALFSTEP(B_, NB_, tt) do { \
                const bool more_ = (tt) + 1 < nt; const char* a1 = cA + (size_t)((tt) + 1) * kstep; const char* b1 = cB + (size_t)((tt) + 1) * kstep; \
                if (more_) { PG8_GLD(rb0, b1, voffB); PG8_GLD(rb1, b1 + hstep, voffB); } \
                PG8_LDB(B0, B_, 0); PG8_LDB(B1, B_, 1); PG8_LDA(At, B_, 0); PG8_MMA(0, 0, At, B0); PG8_MMA(0, 1, At, B1); \
                if (more_) { PG8_LST(PG8_SB(NB_, 0), rb0); PG8_LST(PG8_SB(NB_, 1), rb1); PG8_GLD(rb0, a1, voffA); PG8_GLD(rb1, a1 + hstep, voffA); } \
                PG8_LDA(At, B_, 1); PG8_MMA(1, 0, At, B0); PG8_MMA(1, 1, At, B1); \
                if (more_) { PG8_LST(PG8_SA(NB_, 0), rb0); PG8_LST(PG8_SA(NB_, 1), rb1); } \
                __syncthreads(); } while (0)
            for (int t = 0; t < nt; t += 2) { PG8_HALFSTEP(0, 1, t); PG8_HALFSTEP(1, 0, t + 1); }
#undef PG8_HALFSTEP
            E(acc, cur_, wr, wc, fr, fq);
        }
#undef PG8_GLD
#undef PG8_LST
    }
#else
    Unit cur, nxt; int ui = 0;
    if (!S.next(0, cur)) return;
    f32x4 acc[2][2][4][2];
#pragma unroll
    for (int a = 0; a < 2; ++a)
#pragma unroll
        for (int b = 0; b < 2; ++b)
#pragma unroll
            for (int m = 0; m < 4; ++m)
#pragma unroll
                for (int n = 0; n < 2; ++n) acc[a][b][m][n] = (f32x4){0.f, 0.f, 0.f, 0.f};
    bf16x8 At[4][2], B0[2][2], B1[2][2];
    const char* cA = (const char*)g.A + (size_t)cur.pm * tstep; const char* cB = (const char*)g.Bt + (size_t)cur.pn * tstep;
    S.a_ready(cur);
    if constexpr (SP2) {
        PG8_STAGE(PG8_SB(0, 0), cB, voffB); PG8_STAGE(PG8_SB(0, 1), cB + hstep, voffB); PG8_STAGE(PG8_SA(0, 0), cA, voffA); PG8_STAGE(PG8_SA(0, 1), cA + hstep, voffA);
        if (wr == 1) PG8_BAR;
        PG8_WAIT_V(2); PG8_BAR;
        PG8_STAGE(PG8_SB(1, 0), cB + kstep, voffB); PG8_STAGE(PG8_SA(1, 0), cA + kstep, voffA); PG8_STAGE(PG8_SB(1, 1), cB + hstep + kstep, voffB);
        PG8_WAIT_V(6); PG8_BAR;
    } else {
        PG8_STAGE(PG8_SB(0, 0), cB, voffB); PG8_STAGE(PG8_SA(0, 0), cA, voffA); PG8_STAGE(PG8_SB(0, 1), cB + hstep, voffB); PG8_STAGE(PG8_SA(0, 1), cA + hstep, voffA);
        if (wr == 1) PG8_BAR;
        PG8_WAIT_V(4); PG8_BAR;
        PG8_STAGE(PG8_SB(1, 0), cB + kstep, voffB); PG8_STAGE(PG8_SA(1, 0), cA + kstep, voffA); PG8_STAGE(PG8_SB(1, 1), cB + hstep + kstep, voffB);
        PG8_WAIT_V(6); PG8_BAR;
    }
    for (;;) {
        const bool has_next = S.next(ui + 1, nxt);
        const char* nA = has_next ? (const char*)g.A + (size_t)nxt.pm * tstep : cA; const char* nB = has_next ? (const char*)g.Bt + (size_t)nxt.pn * tstep : cB;
        for (int t = 0; t < nt; t += 2) {
            const bool last = (t == nt - 2);
            const char* a1 = cA + (size_t)(t + 1) * kstep;
            const char* a2 = last ? nA : cA + (size_t)(t + 2) * kstep; const char* b2 = last ? nB : cB + (size_t)(t + 2) * kstep;
            const char* a3 = a2 + kstep; const char* b3 = b2 + kstep;
            if (last && has_next) S.a_ready(nxt);
            if constexpr (SP2) {
            PG8_LDB(B0, 0, 0); PG8_LDB(B1, 0, 1); PG8_SCHED; PG8_LDA(At, 0, 0); PG8_STAGE(PG8_SA(1, 1), a1 + hstep, voffA);
            PG8_WAIT_V(8); PG8_WAIT_L(0); PG8_BAR; PG8_MMA(0, 0, At, B0); PG8_MMA(0, 1, At, B1); PG8_BAR; PG8_SCHED;
            PG8_LDA(At, 0, 1); PG8_STAGE(PG8_SB(0, 0), b2, voffB); PG8_STAGE(PG8_SB(0, 1), b2 + hstep, voffB); PG8_STAGE(PG8_SA(0, 0), a2, voffA);
            PG8_WAIT_V(8); PG8_WAIT_L(0); PG8_BAR; PG8_MMA(1, 0, At, B0); PG8_MMA(1, 1, At, B1); PG8_BAR; PG8_SCHED;
            PG8_LDB(B0, 1, 0); PG8_LDB(B1, 1, 1); PG8_SCHED; PG8_LDA(At, 1, 0); PG8_STAGE(PG8_SA(0, 1), a2 + hstep, voffA);
            PG8_WAIT_V(8); PG8_WAIT_L(0); PG8_BAR; PG8_MMA(0, 0, At, B0); PG8_MMA(0, 1, At, B1); PG8_BAR; PG8_SCHED;
            PG8_LDA(At, 1, 1); PG8_STAGE(PG8_SB(1, 0), b3, voffB); PG8_STAGE(PG8_SB(1, 1), b3 + hstep, voffB); PG8_STAGE(PG8_SA(1, 0), a3, voffA);
            PG8_WAIT_V(8); PG8_WAIT_L(0); PG8_BAR; PG8_MMA(1, 0, At, B0); PG8_MMA(1, 1, At, B1); PG8_BAR; PG8_SCHED;
            } else {
            PG8_LDB(B0, 0, 0); PG8_SCHED; PG8_LDA(At, 0, 0); PG8_STAGE(PG8_SA(1, 1), a1 + hstep, voffA);
            PG8_WAIT_L(8); PG8_BAR; PG8_WAIT_L(0); PG8_MMA(0, 0, At, B0); PG8_BAR; PG8_SCHED;
            PG8_LDB(B1, 0, 1); PG8_STAGE(PG8_SB(0, 0), b2, voffB);
            PG8_BAR; PG8_WAIT_L(0); PG8_MMA(0, 1, At, B1); PG8_BAR;
            PG8_LDA(At, 0, 1); PG8_STAGE(PG8_SA(0, 0), a2, voffA);
            PG8_BAR; PG8_WAIT_L(0); PG8_MMA(1, 0, At, B0); PG8_BAR; PG8_SCHED;
            PG8_STAGE(PG8_SB(0, 1), b2 + hstep, voffB);
            PG8_WAIT_V(6); PG8_BAR; PG8_MMA(1, 1, At, B1); PG8_BAR;
            PG8_LDB(B0, 1, 0); PG8_SCHED; PG8_LDA(At, 1, 0); PG8_STAGE(PG8_SA(0, 1), a2 + hstep, voffA);
            PG8_WAIT_L(8); PG8_BAR; PG8_WAIT_L(0); PG8_MMA(0, 0, At, B0); PG8_BAR; PG8_SCHED;
            PG8_LDB(B1, 1, 1); PG8_STAGE(PG8_SB(1, 0), b3, voffB);
            PG8_BAR; PG8_WAIT_L(0); PG8_MMA(0, 1, At, B1); PG8_BAR;
            PG8_LDA(At, 1, 1); PG8_STAGE(PG8_SA(1, 0), a3, voffA);
            PG8_BAR; PG8_WAIT_L(0); PG8_MMA(1, 0, At, B0); PG8_BAR; PG8_SCHED;
            PG8_STAGE(PG8_SB(1, 1), b3 + hstep, voffB);
            PG8_WAIT_V(6); PG8_BAR; PG8_MMA(1, 1, At, B1); PG8_BAR;
            }
        }
        if constexpr (ALIGN_EPI) { if (wr == 0) PG8_BAR; }
        if constexpr (!Epi::AFTER_DRAIN) { E(acc, cur, wr, wc, fr, fq); S.done(cur); }
        if (!has_next) break;
#pragma unroll
        for (int a = 0; a < 2; ++a)
#pragma unroll
            for (int b = 0; b < 2; ++b)
#pragma unroll
                for (int m = 0; m < 4; ++m)
#pragma unroll
                    for (int n = 0; n < 2; ++n) acc[a][b][m][n] = (f32x4){0.f, 0.f, 0.f, 0.f};
        cur = nxt; cA = nA; cB = nB; ++ui;
        if constexpr (ALIGN_EPI) { if (wr == 1) PG8_BAR; }
    }
    PG8_WAIT_V(0);
    if constexpr (!ALIGN_EPI) { if (wr == 0) PG8_BAR; }
    PG8_BAR;
    if constexpr (Epi::AFTER_DRAIN) { E.fused(acc, cur, wr, wc, fr, fq, lds, wid, lane); S.done(cur); }
#endif
#undef PG8_SA
#undef PG8_SB
#undef PG8_STAGE
#undef PG8_LDA
#undef PG8_LDB
#undef PG8_MMA
#undef PG8_WAIT_V
#undef PG8_WAIT_L
#undef PG8_BAR
#undef PG8_SCHED
}
}
#include <hip/hip_bf16.h>
#include <cmath>
namespace attn_body {
using bf16=__hip_bfloat16;
using bf16x8=__attribute__((ext_vector_type(8)))short;
using s16x4=__attribute__((ext_vector_type(4)))short;
using f32x16=__attribute__((ext_vector_type(16)))float;
using u32x4=__attribute__((ext_vector_type(4)))unsigned;
using f32x4v=__attribute__((ext_vector_type(4)))float;
constexpr int BATCH=16,NHEAD=8,SEQ=4096,D=64,DM=NHEAD*D;
constexpr int NW=8,QBLK=32,QB=QBLK*NW,KVBLK=64,NQB=SEQ/QB;
constexpr int ATTN_PITCH=DM, ATTN_UNIT_ROWS=QB;
__device__ __forceinline__ int crow(int r,int hi){return (r&3)+8*(r>>2)+4*hi;}
#define SBAR() __builtin_amdgcn_sched_barrier(0)
__device__ __forceinline__ void cmask(f32x16&p0,f32x16&p1,int jb,int qrel,int hi){
  const float NEG=-INFINITY; int kb=64*jb+4*hi;
  #pragma unroll
  for(int r=0;r<16;++r){int kv=kb+(r&3)+8*(r>>2); if(kv>qrel)p0[r]=NEG; if(kv+32>qrel)p1[r]=NEG;}
}

constexpr int NSLOT=3, SLOTB=8192;
constexpr int LDS_K=0, LDS_V=NSLOT*SLOTB, LDS_WS=2*NSLOT*SLOTB, LDS_OST=LDS_WS+NW*64*4, LDS_CB=LDS_OST+NW*4096, LDS_BYTES=LDS_CB+SEQ*4;
constexpr float FSKIP=100.f;
constexpr float C2=0.125f*1.4426950408889634f;
__device__ __forceinline__ void glds16(const void*gsrc,unsigned lds_dst){unsigned keep;
  asm volatile("s_mov_b32 %0, m0\n\ts_mov_b32 m0, %2\n\ts_nop 0\n\tglobal_load_lds_dwordx4 %1, off\n\ts_mov_b32 m0, %0":"=&s"(keep):"v"(gsrc),"s"(lds_dst):"memory");}
__device__ __forceinline__ float max3f(float a,float b,float c){float r;asm("v_max3_f32 %0, %1, %2, %3":"=v"(r):"v"(a),"v"(b),"v"(c));return r;}
__device__ __forceinline__ float max2f(float a,float b){float r;asm("v_max_f32_e32 %0, %1, %2":"=v"(r):"v"(a),"v"(b));return r;}
__device__ __forceinline__ float fadd_s(float a,float b){float r;asm("v_add_f32_e32 %0, %1, %2":"=v"(r):"v"(a),"v"(b));return r;}
__device__ __forceinline__ float fsub_s(float a,float b){float r;asm("v_sub_f32_e32 %0, %1, %2":"=v"(r):"v"(a),"v"(b));return r;}
typedef float f32x2_t __attribute__((ext_vector_type(2))); typedef __bf16 bf16x2_t __attribute__((ext_vector_type(2)));
__device__ __forceinline__ unsigned cvtpk_s(float lo,float hi){f32x2_t v={lo,hi};bf16x2_t b=__builtin_convertvector(v,bf16x2_t);return __builtin_bit_cast(unsigned,b);}
#define WAIT_BAR(N) asm volatile("s_waitcnt vmcnt(" #N ") lgkmcnt(0)\n\ts_barrier":::"memory")

__device__ __forceinline__ void qkt(f32x16&p0,f32x16&p1,const char*Kslot,const bf16x8*qr,const f32x16&negm,int r32,int hi){
  const char*kb=Kslot+hi*1024+r32*16;
  #pragma unroll
  for(int d0=0;d0<4;++d0){
    const bf16x8 b0=*reinterpret_cast<const bf16x8*>(kb+d0*2048);
    const bf16x8 b1=*reinterpret_cast<const bf16x8*>(kb+d0*2048+512);
    if(d0==0){p0=__builtin_amdgcn_mfma_f32_32x32x16_bf16(b0,qr[0],negm,0,0,0);p1=__builtin_amdgcn_mfma_f32_32x32x16_bf16(b1,qr[0],negm,0,0,0);}
    else{p0=__builtin_amdgcn_mfma_f32_32x32x16_bf16(b0,qr[d0],p0,0,0,0);p1=__builtin_amdgcn_mfma_f32_32x32x16_bf16(b1,qr[d0],p1,0,0,0);}}
}
typedef __attribute__((address_space(3))) const char* lds_cptr;
typedef short v4i16_t __attribute__((ext_vector_type(4)));
__device__ __forceinline__ void kload8(bf16x8*kf,lds_cptr kp){
  kf[0]=*(const __attribute__((address_space(3))) bf16x8*)(kp);      kf[1]=*(const __attribute__((address_space(3))) bf16x8*)(kp+512);
  kf[2]=*(const __attribute__((address_space(3))) bf16x8*)(kp+2048); kf[3]=*(const __attribute__((address_space(3))) bf16x8*)(kp+2560);
  kf[4]=*(const __attribute__((address_space(3))) bf16x8*)(kp+4096); kf[5]=*(const __attribute__((address_space(3))) bf16x8*)(kp+4608);
  kf[6]=*(const __attribute__((address_space(3))) bf16x8*)(kp+6144); kf[7]=*(const __attribute__((address_space(3))) bf16x8*)(kp+6656);
}
__device__ __forceinline__ void kload2(bf16x8*kf,lds_cptr kp,int j){ kf[2*j]=*(const __attribute__((address_space(3))) bf16x8*)(kp+j*2048); kf[2*j+1]=*(const __attribute__((address_space(3))) bf16x8*)(kp+j*2048+512); }
__device__ __forceinline__ s16x4 vtr(lds_cptr p){ return __builtin_bit_cast(s16x4,__builtin_amdgcn_ds_read_tr16_b64_v4i16((__attribute__((address_space(3))) v4i16_t*)p)); }
__device__ __forceinline__ float rowmax(const f32x16&p0,const f32x16&p1){
  float a=max3f(p0[0],p0[1],p1[0]),b=max3f(p0[2],p0[3],p1[1]);a=max3f(a,p1[2],p1[3]);
  #pragma unroll
  for(int r=4;r<16;r+=4){a=max3f(a,p0[r],p0[r+1]);b=max3f(b,p0[r+2],p0[r+3]);a=max3f(a,p1[r],p1[r+1]);b=max3f(b,p1[r+2],p1[r+3]);}
  const float m=max2f(a,b);
  auto rr=__builtin_amdgcn_permlane32_swap(__float_as_uint(m),__float_as_uint(m),false,false);
  return max2f(__uint_as_float(rr[0]),__uint_as_float(rr[1]));
}
__device__ __forceinline__ void pv(f32x16*o,int vb,bf16x8 pa0,bf16x8 pa1,bf16x8 pa2,bf16x8 pa3){
  #pragma unroll
  for(int d0=0;d0<2;++d0){s16x4 lo[4],hi[4];
    #pragma unroll
    for(int ks=0;ks<4;++ks){
      asm volatile("ds_read_b64_tr_b16 %0,%1 offset:%c2":"=&v"(lo[ks]):"v"(vb),"i"(d0*4096+ks*1024):"memory");
      asm volatile("ds_read_b64_tr_b16 %0,%1 offset:%c2":"=&v"(hi[ks]):"v"(vb),"i"(d0*4096+ks*1024+512):"memory");}
    asm volatile("s_waitcnt lgkmcnt(0)":::"memory");SBAR();
    #define PK(k) (bf16x8){lo[k][0],lo[k][1],lo[k][2],lo[k][3],hi[k][0],hi[k][1],hi[k][2],hi[k][3]}
    o[d0]=__builtin_amdgcn_mfma_f32_32x32x16_bf16(pa0,PK(0),o[d0],0,0,0);
    o[d0]=__builtin_amdgcn_mfma_f32_32x32x16_bf16(pa1,PK(1),o[d0],0,0,0);
    o[d0]=__builtin_amdgcn_mfma_f32_32x32x16_bf16(pa2,PK(2),o[d0],0,0,0);
    o[d0]=__builtin_amdgcn_mfma_f32_32x32x16_bf16(pa3,PK(3),o[d0],0,0,0);
    #undef PK
  }
}

#ifndef ATTN_STORE16
#define ATTN_STORE16(p,v) (*(u32x4*)(p)=(v))
#endif
template<int THRL> __device__ __forceinline__ void attn_unit(int b,int h,int qb,const bf16*Q,const bf16*__restrict__ K,const bf16*__restrict__ V,bf16*O,const float*__restrict__ Cbh,char*shm){
  int tid_=threadIdx.x; asm volatile("":"+v"(tid_));
  const int tid=tid_,lane=tid&63,r32=lane&31,hi=lane>>5; const int wid=__builtin_amdgcn_readfirstlane(tid>>6);
  const long rowbase=(long)b*SEQ; const int q0=qb*QB;
  int t0;
  { const int NTf=(q0+QB)/KVBLK; const float cref=Cbh[q0]; const float ce=(lane<NTf)?Cbh[64*lane+63]:cref;
    const unsigned long long sk=__ballot((lane<NTf)&&((cref-ce)<-FSKIP));
    int t_=(int)__builtin_popcountll(sk); t_=(t_<NTf-4?t_:NTf-4)&~1; t0=__builtin_amdgcn_readfirstlane(t_); }
  const bf16*Qw=Q+(rowbase+q0+wid*QBLK)*DM+h*D;
  const bf16*Kh=K+(rowbase+(long)t0*KVBLK)*DM+h*D,*Vh=V+(rowbase+(long)t0*KVBLK)*DM+h*D;
  const unsigned lds0=(unsigned)(uintptr_t)shm;
  float*wsf=(float*)(shm+LDS_WS)+wid*64;
  const bf16*ksrc=Kh+(long)lane*DM+wid*8;
  const bf16*vsrc=Vh+(long)(16*(wid&3)+(lane>>2))*DM+(wid>>2)*32+(lane&3)*8;
  const unsigned kdst=lds0+LDS_K+wid*1024, vdst=lds0+LDS_V+wid*1024;
  #define DMA_K(t,slot) glds16(ksrc+(long)(t)*KVBLK*DM,(unsigned)__builtin_amdgcn_readfirstlane(kdst+(slot)))
  #define DMA_V(t,slot) glds16(vsrc+(long)(t)*KVBLK*DM,(unsigned)__builtin_amdgcn_readfirstlane(vdst+(slot)))
  const int vb0=(int)(lds0+LDS_V)+((lane>>4)&1)*32+(lane&3)*8+(4*hi+((lane&15)>>2))*64;
  const char*Kbase=shm+LDS_K; bf16x8 kf[8];
  const lds_cptr shm3=(lds_cptr)shm; const lds_cptr kp0=shm3+LDS_K+hi*1024+r32*16; const lds_cptr vp0=shm3+LDS_V+((lane>>4)&1)*32+(lane&3)*8+(4*hi+((lane&15)>>2))*64;
  const int NT=(q0+QB)/KVBLK-t0;
  typedef __attribute__((address_space(3))) f32x4v* cb_wptr; typedef __attribute__((address_space(3))) const f32x4v* cb_lptr;
  float cq2;
  { const float c2ref=Cbh[q0]; const int nk4=(q0+QB-t0*KVBLK)>>2; const float*Cs=Cbh+t0*KVBLK; cb_wptr cw=(cb_wptr)((__attribute__((address_space(3))) char*)shm+LDS_CB);
    for(int i=tid;i<nk4;i+=NW*64){ f32x4v v=*(const f32x4v*)(Cs+4*i); v=v-c2ref; cw[i]=v; }
    cq2=Cbh[q0+wid*QBLK+r32]-c2ref;
    asm volatile("s_waitcnt vmcnt(0) lgkmcnt(0)":::"memory"); }
  DMA_K(0,0);DMA_V(0,0);DMA_K(1,SLOTB);
  bf16x8 qr[4];
  #pragma unroll
  for(int d0=0;d0<4;++d0)qr[d0]=*reinterpret_cast<const bf16x8*>(&Qw[(long)r32*DM+d0*16+hi*8]);
  float mhat=0.f,l_reg=0.f;f32x16 o[2];o[0]=f32x16{};o[1]=f32x16{};const f32x16 zz16=f32x16{}; float mq=-cq2;
  const int qrel=wid*QBLK+r32;
  #define CMASK(P0,P1,t) do{int jb_=(t)-(NT-4); if(jb_>=0)cmask(P0,P1,jb_,qrel,hi);}while(0)
  const cb_lptr cb0=(cb_lptr)((__attribute__((address_space(3))) const char*)shm+LDS_CB+hi*16);
  #define BIAS(P0,P1,t) do{ const cb_lptr cp_=cb0+(t)*16; \
    _Pragma("unroll") for(int h_=0;h_<2;++h_){ \
    _Pragma("unroll") for(int j_=2*h_;j_<2*h_+2;++j_){ const f32x4v a_=cp_[2*j_]+mq, b_=cp_[8+2*j_]+mq; \
      P0[4*j_]-=a_[0];P0[4*j_+1]-=a_[1];P0[4*j_+2]-=a_[2];P0[4*j_+3]-=a_[3]; P1[4*j_]-=b_[0];P1[4*j_+1]-=b_[1];P1[4*j_+2]-=b_[2];P1[4*j_+3]-=b_[3]; } SBAR(); } }while(0)
  bool resc=false;
  #define START(P0,P1) do{ const float rm=__builtin_fmaxf(rowmax(P0,P1),0.f); resc=false; \
    { const float dl=rm; mhat=fadd_s(mhat,dl); \
      _Pragma("unroll") for(int r=0;r<16;++r){P0[r]=fsub_s(P0[r],dl);P1[r]=fsub_s(P1[r],dl);} \
      mq=mhat-cq2; } \
    _Pragma("unroll") for(int r=0;r<16;++r)P0[r]=__builtin_amdgcn_exp2f(P0[r]); }while(0)
  #define RESC() do{ if(resc){ asm volatile("s_waitcnt lgkmcnt(0)":::"memory"); \
      _Pragma("unroll") for(int d_=0;d_<2;++d_) _Pragma("unroll") for(int r=0;r<16;++r)o[d_][r]*=wsf[crow(r,hi)]; } }while(0)
  f32x16 pA0,pA1,pB0,pB1;
  int sl_prev=0,sl_cur=0,sl_next=SLOTB;
  #define ROT() do{sl_prev=sl_cur;sl_cur=sl_next;sl_next=(sl_next==(NSLOT-1)*SLOTB)?0:sl_next+SLOTB;}while(0)
  DMA_K(2,2*SLOTB);
  WAIT_BAR(3);
  qkt(pA0,pA1,Kbase,qr,zz16,r32,hi);asm volatile("s_nop 15\n\ts_nop 7":"+v"(pA0),"+v"(pA1));BIAS(pA0,pA1,0);CMASK(pA0,pA1,0);
  START(pA0,pA1);
  _Pragma("unroll") for(int r=0;r<16;++r)pA1[r]=__builtin_amdgcn_exp2f(pA1[r]);
  WAIT_BAR(0);
  DMA_K(3,0);DMA_V(1,SLOTB);
  ROT();
  kload8(kf,kp0+sl_cur);
  WAIT_BAR(2);
  s16x4 vlo[8],vhi[8]; u32x4 pw0,pw1,pw2,pw3;
  #define PKW(P,B) cvtpk_s(P[B],P[B+1])
  #define PAF(k) __builtin_bit_cast(bf16x8,pw##k)
  #define VFR(i) (bf16x8){vlo[i][0],vlo[i][1],vlo[i][2],vlo[i][3],vhi[i][0],vhi[i][1],vhi[i][2],vhi[i][3]}
  #define PIN(x) asm volatile("":"+v"(x))
  #define MX3(a,b,c) __builtin_fmaxf(__builtin_fmaxf((a),(b)),(c))
  #define GAPA(MF,A0,A1,A2,A3,W0,W1,PW) do{ MF; sacc+=A0; sacc+=A1; sacc+=A2; sacc+=A3; PIN(sacc); W0; W1; PIN(PW); SBAR(); }while(0)
  #define EX(v) __builtin_amdgcn_exp2f(v)
  #define GAPB(MF,X,B) do{ MF; X[B]=EX(X[B]); X[B+1]=EX(X[B+1]); X[B+2]=EX(X[B+2]); X[B+3]=EX(X[B+3]); PIN(X); SBAR(); }while(0)
  #define VRD(i) do{ vlo[i]=vtr(vp_+(((i)>>2)*4096+((i)&3)*1024)); vhi[i]=vtr(vp_+(((i)>>2)*4096+((i)&3)*1024+512)); }while(0)
  #define KRD(G,j) do{ if(G){ kload2(kf,kp0+sl_next,j); SBAR(); } }while(0)
  #define STEP(C0,C1,P0,P1,t,GK,GV,GL) do{ SBAR(); \
    const lds_cptr vp_=vp0+sl_prev; \
    VRD(0); SBAR(); float sacc=(P0[0]+P0[1]); \
    GAPA(C0=__builtin_amdgcn_mfma_f32_32x32x16_bf16(kf[0],qr[0],zz16,0,0,0), P0[2],P0[3],P0[4],P0[5],     pw0[0]=PKW(P0,0), pw0[1]=PKW(P0,2), pw0); \
    VRD(4); SBAR(); GAPA(C1=__builtin_amdgcn_mfma_f32_32x32x16_bf16(kf[1],qr[0],zz16,0,0,0), P0[6],P0[7],P0[8],P0[9],     pw0[2]=PKW(P0,4), pw0[3]=PKW(P0,6), pw0); \
    VRD(1); SBAR(); GAPA(C0=__builtin_amdgcn_mfma_f32_32x32x16_bf16(kf[2],qr[1],C0,0,0,0),   P0[10],P0[11],P0[12],P0[13], pw1[0]=PKW(P0,8), pw1[1]=PKW(P0,10), pw1); \
    VRD(5); SBAR(); GAPA(C1=__builtin_amdgcn_mfma_f32_32x32x16_bf16(kf[3],qr[1],C1,0,0,0),   P0[14],P0[15],P1[0],P1[1],   pw1[2]=PKW(P0,12),pw1[3]=PKW(P0,14), pw1); \
    VRD(2); SBAR(); GAPA(C0=__builtin_amdgcn_mfma_f32_32x32x16_bf16(kf[4],qr[2],C0,0,0,0),   P1[2],P1[3],P1[4],P1[5],     pw2[0]=PKW(P1,0), pw2[1]=PKW(P1,2), pw2); \
    VRD(6); SBAR(); GAPA(C1=__builtin_amdgcn_mfma_f32_32x32x16_bf16(kf[5],qr[2],C1,0,0,0),   P1[6],P1[7],P1[8],P1[9],     pw2[2]=PKW(P1,4), pw2[3]=PKW(P1,6), pw2); \
    VRD(3); SBAR(); GAPA(C0=__builtin_amdgcn_mfma_f32_32x32x16_bf16(kf[6],qr[3],C0,0,0,0),   P1[10],P1[11],P1[12],P1[13], pw3[0]=PKW(P1,8), pw3[1]=PKW(P1,10), pw3); \
    VRD(7); SBAR(); GAPA(C1=__builtin_amdgcn_mfma_f32_32x32x16_bf16(kf[7],qr[3],C1,0,0,0),   P1[14],P1[15],0.f,0.f,       pw3[2]=PKW(P1,12),pw3[3]=PKW(P1,14), pw3); \
    l_reg+=sacc; \
    if(GK){DMA_K((t)+3,sl_cur);} if(GV){DMA_V((t)+1,sl_next);} \
    BIAS(C0,C1,t); CMASK(C0,C1,t); \
    { float a=MX3(C0[0],C0[1],C1[0]),b=MX3(C0[2],C0[3],C1[1]); a=MX3(a,C1[2],C1[3]); \
      _Pragma("unroll") for(int r=4;r<16;r+=4){a=MX3(a,C0[r],C0[r+1]);b=MX3(b,C0[r+2],C0[r+3]);a=MX3(a,C1[r],C1[r+1]);b=MX3(b,C1[r+2],C1[r+3]);} \
      float rm=__builtin_fmaxf(a,b); { auto rr=__builtin_amdgcn_permlane32_swap(__float_as_uint(rm),__float_as_uint(rm),false,false); rm=__builtin_fmaxf(__uint_as_float(rr[0]),__uint_as_float(rr[1])); } \
      resc=false; \
      if(__builtin_expect(__any(rm>(float)THRL),0)){ const float dl=__builtin_fmaxf(rm,0.f); mhat+=dl; \
        _Pragma("unroll") for(int r=0;r<16;++r){C0[r]-=dl;C1[r]-=dl;} \
        mq=mhat-cq2; \
        const float f=__builtin_amdgcn_exp2f(-dl); l_reg*=f; if(hi==0)wsf[r32]=f; resc=true; } } \
    SBAR(); \
    GAPB(o[0]=__builtin_amdgcn_mfma_f32_32x32x16_bf16(PAF(0),VFR(0),o[0],0,0,0), C0,0); \
    GAPB(o[1]=__builtin_amdgcn_mfma_f32_32x32x16_bf16(PAF(0),VFR(4),o[1],0,0,0), C0,4); \
    KRD(GL,0); GAPB(o[0]=__builtin_amdgcn_mfma_f32_32x32x16_bf16(PAF(1),VFR(1),o[0],0,0,0), C0,8); \
    KRD(GL,1); GAPB(o[1]=__builtin_amdgcn_mfma_f32_32x32x16_bf16(PAF(1),VFR(5),o[1],0,0,0), C0,12); \
    KRD(GL,2); GAPB(o[0]=__builtin_amdgcn_mfma_f32_32x32x16_bf16(PAF(2),VFR(2),o[0],0,0,0), C1,0); \
    KRD(GL,3); GAPB(o[1]=__builtin_amdgcn_mfma_f32_32x32x16_bf16(PAF(2),VFR(6),o[1],0,0,0), C1,4); \
    GAPB(o[0]=__builtin_amdgcn_mfma_f32_32x32x16_bf16(PAF(3),VFR(3),o[0],0,0,0), C1,8); \
    GAPB(o[1]=__builtin_amdgcn_mfma_f32_32x32x16_bf16(PAF(3),VFR(7),o[1],0,0,0), C1,12); \
    }while(0)
  int t=1;
  #undef CMASK
  #define CMASK(P0,P1,t) do{}while(0)
  for(;t+5<NT;t+=2){
    STEP(pB0,pB1,pA0,pA1,t,true,true,true);     WAIT_BAR(2); RESC(); ROT();
    STEP(pA0,pA1,pB0,pB1,t+1,true,true,true);   WAIT_BAR(2); RESC(); ROT();
  }
  #undef CMASK
  #define CMASK(P0,P1,t) do{int jb_=(t)-(NT-4); if(jb_>=0)cmask(P0,P1,jb_,qrel,hi);}while(0)
  #define ENDW(tt) do{ if((tt)+3<NT){WAIT_BAR(2);} else if((tt)+2<NT){WAIT_BAR(1);} else {WAIT_BAR(0);} }while(0)
  for(;t+1<NT;t+=2){
    STEP(pB0,pB1,pA0,pA1,t,(t+3<NT),(t+1<NT),(t+1<NT));       ENDW(t);   RESC(); ROT();
    STEP(pA0,pA1,pB0,pB1,t+1,(t+4<NT),(t+2<NT),(t+2<NT));     ENDW(t+1); RESC(); ROT();
  }
  STEP(pB0,pB1,pA0,pA1,NT-1,false,false,false); RESC();
  { float sacc=pB0[0]+pB0[1]; _Pragma("unroll") for(int r=2;r<16;++r)sacc+=pB0[r]; _Pragma("unroll") for(int r=0;r<16;++r)sacc+=pB1[r]; l_reg+=sacc;
    pw0=(u32x4){PKW(pB0,0),PKW(pB0,2),PKW(pB0,4),PKW(pB0,6)};pw1=(u32x4){PKW(pB0,8),PKW(pB0,10),PKW(pB0,12),PKW(pB0,14)};pw2=(u32x4){PKW(pB1,0),PKW(pB1,2),PKW(pB1,4),PKW(pB1,6)};pw3=(u32x4){PKW(pB1,8),PKW(pB1,10),PKW(pB1,12),PKW(pB1,14)};
    SBAR(); pv(o,vb0+sl_cur,PAF(0),PAF(1),PAF(2),PAF(3)); }
  #undef PKW
  #undef PAF
  #undef VFR
  #undef PIN
  #undef MX3
  #undef GAPA
  #undef GAPB
  #undef EX
  #undef VRD
  #undef KRD
  #undef STEP
  #undef ENDW
  {auto rr=__builtin_amdgcn_permlane32_swap(__float_as_uint(l_reg),__float_as_uint(l_reg),false,false);l_reg=__uint_as_float(rr[0])+__uint_as_float(rr[1]);}
  if(hi==0)wsf[32+r32]=l_reg;asm volatile("s_waitcnt lgkmcnt(0)":::"memory");
  float rli[16];
  #pragma unroll
  for(int r=0;r<16;++r)rli[r]=__builtin_amdgcn_rcpf(wsf[32+crow(r,hi)]);
  bf16*Ow=O+(rowbase+q0+wid*QBLK)*DM+h*D;
  { bf16*stg=(bf16*)(shm+LDS_OST)+wid*2048;
    #pragma unroll
    for(int r=0;r<16;++r){const int orow=crow(r,hi);
      #pragma unroll
      for(int d0=0;d0<2;++d0)stg[orow*64+d0*32+r32]=__float2bfloat16(o[d0][r]*rli[r]);}
    asm volatile("s_waitcnt lgkmcnt(0)":::"memory");
    #pragma unroll
    for(int i=0;i<4;++i){const int row=i*8+(lane>>3),ch=lane&7; const u32x4 v=*(const u32x4*)(stg+row*64+ch*8); ATTN_STORE16(Ow+(long)row*DM+ch*8,v);} }
  asm volatile("s_waitcnt lgkmcnt(0)\n\ts_barrier":::"memory");
  #undef BIAS
  #undef DMA_K
  #undef DMA_V
  #undef CMASK
  #undef START
  #undef RESC
  #undef ROT
}
constexpr int ATTN_LDS_BYTES=LDS_BYTES;
#undef SBAR
#undef WAIT_BAR
}
#define LAS __attribute__((address_space(3)))
typedef unsigned short bf16;
typedef float f32x4 __attribute__((ext_vector_type(4)));
typedef unsigned v4u __attribute__((ext_vector_type(4)));
typedef unsigned v2u __attribute__((ext_vector_type(2)));
typedef short bf16x8 __attribute__((ext_vector_type(8)));
typedef short bf16x4 __attribute__((ext_vector_type(4)));
constexpr int NWAVES = 8, NTHR = 512;
constexpr int BATCH = 16, SEQ = 4096, T = BATCH * SEQ, D = 1024, FF = 4096, PLE = 256, NIN = 5640, NPROJ = 5632, HGW = 512, NHF = 8;
constexpr float LN_EPS = 1e-5f, RMS_EPS = 1e-6f, ALPHA = 1.189207115002721f, LOG2E = 1.4426950408889634f;
constexpr size_t MiB = 1u << 20, UNIT = 64 * MiB;
constexpr size_t WS_CTL = 0;
constexpr size_t WS_LF = 1 * MiB;
constexpr size_t WS_C2 = 3 * MiB;
constexpr size_t WS_WIN = 6 * MiB;
constexpr size_t WS_WA = 17 * MiB, WS_WB = 18 * MiB, WS_WO = 19 * MiB, WS_WPG = 21 * MiB, WS_WP = 23 * MiB;
constexpr size_t WS_WFF1 = 24 * MiB, WS_WFF2 = 32 * MiB;
constexpr size_t WS_H = 1 * UNIT;
constexpr size_t WS_PROJ = 3 * UNIT;
constexpr size_t WS_YA = 14 * UNIT;
constexpr size_t WS_PB = 15 * UNIT;
constexpr size_t WS_TMP = 3 * UNIT, WS_MERGED = 5 * UNIT;
constexpr size_t WS_FF1 = 3 * UNIT;
constexpr size_t WS_PE = 11 * UNIT;
constexpr size_t WS_END = 16 * UNIT;
constexpr int RING_BYTES = 131072, MISC_OFF = RING_BYTES, LDS_BYTES = 147456;

struct Args { const float* in[19]; float* out; unsigned char* ws; };

__device__ __forceinline__ unsigned f2bf(float f) { unsigned u = __builtin_bit_cast(unsigned, f); return (u + 0x7fffu + ((u >> 16) & 1u)) >> 16; }
__device__ __forceinline__ unsigned pk2(float lo, float hi) { return f2bf(lo) | (f2bf(hi) << 16); }
__device__ __forceinline__ float bf2f(unsigned short h) { return __uint_as_float((unsigned)h << 16); }
__device__ __forceinline__ float wave_sum(float v) {
#pragma unroll
    for (int o = 1; o < 64; o <<= 1) v += __shfl_xor(v, o);
    return v;
}
__device__ __forceinline__ void p0_transpose_item(const float* W, int K, int ldw, int nblk, bf16* WT, LAS float* scr, int item, int lane, int split, int shift) {
    const int kb = item / nblk, nb = item % nblk, k0 = 64 * kb, n0 = 32 * nb; const int s0 = n0 + (n0 >= split ? shift : 0);
#pragma unroll 8
    for (int i = 0; i < 32; ++i) { const int kk = 2 * i + (lane >> 5); scr[kk * 33 + (lane & 31)] = W[(size_t)(k0 + kk) * ldw + s0 + (lane & 31)]; }
    asm volatile("s_waitcnt lgkmcnt(0)" ::: "memory");
    const int c = lane & 7;
#pragma unroll
    for (int j = 0; j < 4; ++j) { const int n = (lane >> 3) + 8 * j; const LAS float* s = scr + (8 * c) * 33 + n;
        v4u o; o.x = pk2(s[0 * 33], s[1 * 33]); o.y = pk2(s[2 * 33], s[3 * 33]); o.z = pk2(s[4 * 33], s[5 * 33]); o.w = pk2(s[6 * 33], s[7 * 33]);
        *(v4u*)(WT + (size_t)(n0 + n) * K + k0 + 8 * c) = o; }
    asm volatile("s_waitcnt lgkmcnt(0)" ::: "memory");
}

__device__ __forceinline__ void p0_prologue(const Args& a, LAS unsigned char* lds, int G) {
    int tid_ = threadIdx.x; asm volatile("" : "+v"(tid_)); const int tid = tid_, lane = tid & 63, wave = __builtin_amdgcn_readfirstlane(tid >> 6);
    unsigned char* ws = a.ws;
    if (blockIdx.x == 0 && tid < 64) ((unsigned*)(ws + WS_CTL))[tid] = 0u;
    const int gw = blockIdx.x * NWAVES + wave, NGW = G * NWAVES;
    const float* w_in = a.in[4];
    {
        LAS float* scr = (LAS float*)(lds + wave * 8704);
        constexpr int I_IN = (D / 64) * (NPROJ / 32), I_A = (HGW / 64) * (D / 32), I_O = (D / 64) * (D / 32), I_F1 = (D / 64) * (FF / 32), I_F2 = (FF / 64) * (D / 32), I_P = (PLE / 64) * (D / 32);
        constexpr int NITEMS = I_IN + 2 * I_A + 2 * I_O + I_F1 + I_F2 + I_P;
        for (int it = gw; it < NITEMS; it += NGW) {
            int r = it;
            if (r < I_IN) { p0_transpose_item(w_in, D, NIN, NPROJ / 32, (bf16*)(ws + WS_WIN), scr, r, lane, 3584, 8); continue; } r -= I_IN;
            if (r < I_A) { p0_transpose_item(a.in[8], HGW, D, D / 32, (bf16*)(ws + WS_WA), scr, r, lane, 1 << 30, 0); continue; } r -= I_A;
            if (r < I_A) { p0_transpose_item(a.in[9], HGW, D, D / 32, (bf16*)(ws + WS_WB), scr, r, lane, 1 << 30, 0); continue; } r -= I_A;
            if (r < I_O) { p0_transpose_item(a.in[10], D, D, D / 32, (bf16*)(ws + WS_WO), scr, r, lane, 1 << 30, 0); continue; } r -= I_O;
            if (r < I_O) { p0_transpose_item(a.in[15], D, D, D / 32, (bf16*)(ws + WS_WPG), scr, r, lane, 1 << 30, 0); continue; } r -= I_O;
            if (r < I_F1) { p0_transpose_item(a.in[13], D, FF, FF / 32, (bf16*)(ws + WS_WFF1), scr, r, lane, 1 << 30, 0); continue; } r -= I_F1;
            if (r < I_F2) { p0_transpose_item(a.in[14], FF, D, D / 32, (bf16*)(ws + WS_WFF2), scr, r, lane, 1 << 30, 0); continue; } r -= I_F2;
            p0_transpose_item(a.in[16], PLE, D, D / 32, (bf16*)(ws + WS_WP), scr, r, lane, 1 << 30, 0);
        }
    }
    __syncthreads();
    LAS float* wf = (LAS float*)lds;
    for (int i = tid; i < D * 8; i += NTHR) wf[i] = w_in[(size_t)(i >> 3) * NIN + 3584 + (i & 7)];
    __syncthreads();
    { const float* p = a.in[1]; bf16* pb = (bf16*)(ws + WS_PB);
      for (size_t i = (size_t)blockIdx.x * NTHR + tid; i < (size_t)T * PLE / 8; i += (size_t)G * NTHR) {
          const f32x4 x0 = *(const f32x4*)(p + 8 * i), x1 = *(const f32x4*)(p + 8 * i + 4);
          v4u o; o.x = pk2(x0.x, x0.y); o.y = pk2(x0.z, x0.w); o.z = pk2(x1.x, x1.y); o.w = pk2(x1.z, x1.w); *(v4u*)(pb + 8 * i) = o; } }
    const float* x = a.in[0]; const float* g0 = a.in[2]; const float* b0 = a.in[3]; const float* fb = a.in[7];
    bf16* H = (bf16*)(ws + WS_H); float* LF = (float*)(ws + WS_LF);
    f32x4 gv[4], bv[4];
#pragma unroll
    for (int j = 0; j < 4; ++j) { gv[j] = *(const f32x4*)(g0 + 256 * j + 4 * lane); bv[j] = *(const f32x4*)(b0 + 256 * j + 4 * lane); }
    for (int m = gw; m < T; m += NGW) {
        const f32x4* xr = (const f32x4*)(x + (size_t)m * D) + lane;
        f32x4 v[4]; float s = 0.f;
#pragma unroll
        for (int j = 0; j < 4; ++j) { v[j] = xr[64 * j]; s += (v[j].x + v[j].y) + (v[j].z + v[j].w); }
        const float mean = wave_sum(s) * (1.f / D); float s2 = 0.f;
#pragma unroll
        for (int j = 0; j < 4; ++j) { v[j] = v[j] - mean; s2 += (v[j].x * v[j].x + v[j].y * v[j].y) + (v[j].z * v[j].z + v[j].w * v[j].w); }
        const float rstd = 1.f / sqrtf(wave_sum(s2) * (1.f / D) + LN_EPS);
        unsigned long long* o8 = (unsigned long long*)(H + (size_t)m * D) + lane;
        float fa[8] = {0.f, 0.f, 0.f, 0.f, 0.f, 0.f, 0.f, 0.f};
#pragma unroll
        for (int j = 0; j < 4; ++j) {
            v[j] = v[j] * rstd * gv[j] + bv[j];
            o8[64 * j] = (unsigned long long)pk2(v[j].x, v[j].y) | ((unsigned long long)pk2(v[j].z, v[j].w) << 32);
#pragma unroll
            for (int e = 0; e < 4; ++e) { const LAS f32x4* wp = (const LAS f32x4*)(wf + (256 * j + 4 * lane + e) * 8); const f32x4 w0 = wp[0], w1 = wp[1]; const float hv = v[j][e];
                fa[0] += hv * w0.x; fa[1] += hv * w0.y; fa[2] += hv * w0.z; fa[3] += hv * w0.w; fa[4] += hv * w1.x; fa[5] += hv * w1.y; fa[6] += hv * w1.z; fa[7] += hv * w1.w; }
        }
        float mine = 0.f;
#pragma unroll
        for (int e = 0; e < 8; ++e) { const float t = wave_sum(fa[e]); if (lane == e) mine = t; }
        if (lane < 8) { const float uu = mine + fb[lane]; const float ls = fminf(uu, 0.f) - log1pf(expf(-fabsf(uu))); LF[(size_t)m * 8 + lane] = ls; }
    }
}
__device__ __forceinline__ void fox_cumsum(const Args& a, LAS unsigned char* lds_misc, int item) {
    int tid_ = threadIdx.x; asm volatile("" : "+v"(tid_)); const int tid = tid_, lane = tid & 63, wave = tid >> 6;
    const int b = item >> 3, hd = item & 7;
    const float* LF = (const float*)(a.ws + WS_LF) + (size_t)b * SEQ * 8 + hd; float* C2 = (float*)(a.ws + WS_C2) + (size_t)item * SEQ;
    float v[8]; float run = 0.f;
#pragma unroll
    for (int i = 0; i < 8; ++i) { run += LF[(size_t)(tid * 8 + i) * 8]; v[i] = run; }
    float inc = run;
#pragma unroll
    for (int o = 1; o < 64; o <<= 1) { const float t = __shfl_up(inc, o); if (lane >= o) inc += t; }
    LAS float* wt = (LAS float*)lds_misc;
    if (lane == 63) wt[wave] = inc;
    __syncthreads();
    float pre = inc - run;
    for (int w = 0; w < wave; ++w) pre += wt[w];
#pragma unroll
    for (int i = 0; i < 8; ++i) C2[tid * 8 + i] = (pre + v[i]) * LOG2E;
    __syncthreads();
}
template <bool TO_BF16> __device__ __forceinline__ void ln_pass(const float* src, const float* gam, const float* bet, bf16* ob, float* of, int G) {
    int tid_ = threadIdx.x; asm volatile("" : "+v"(tid_)); const int tid = tid_, lane = tid & 63, wave = __builtin_amdgcn_readfirstlane(tid >> 6);
    const int gw = blockIdx.x * NWAVES + wave, NGW = G * NWAVES;
    f32x4 gv[4], bv[4];
#pragma unroll
    for (int j = 0; j < 4; ++j) { gv[j] = *(const f32x4*)(gam + 256 * j + 4 * lane); bv[j] = *(const f32x4*)(bet + 256 * j + 4 * lane); }
    for (int m = gw; m < T; m += NGW) {
        const f32x4* xr = (const f32x4*)(src + (size_t)m * D) + lane;
        f32x4 v[4]; float s = 0.f;
#pragma unroll
        for (int j = 0; j < 4; ++j) { v[j] = xr[64 * j]; s += (v[j].x + v[j].y) + (v[j].z + v[j].w); }
        const float mean = wave_sum(s) * (1.f / D); float s2 = 0.f;
#pragma unroll
        for (int j = 0; j < 4; ++j) { v[j] = v[j] - mean; s2 += (v[j].x * v[j].x + v[j].y * v[j].y) + (v[j].z * v[j].z + v[j].w * v[j].w); }
        const float rstd = 1.f / sqrtf(wave_sum(s2) * (1.f / D) + LN_EPS);
#pragma unroll
        for (int j = 0; j < 4; ++j) {
            v[j] = v[j] * rstd * gv[j] + bv[j];
            if (TO_BF16) ((unsigned long long*)(ob + (size_t)m * D) + lane)[64 * j] = (unsigned long long)pk2(v[j].x, v[j].y) | ((unsigned long long)pk2(v[j].z, v[j].w) << 32);
            else ((f32x4*)(of + (size_t)m * D) + lane)[64 * j] = v[j];
        }
    }
}
constexpr int HG_C = 32, HG_QP = 0, HG_KP = 8704, HG_KPT = 17408, HG_VT = 27648, HG_DEC = 37888, HG_BUF = 38400, HG_SSQ = 2 * HG_BUF, HG_LDS = HG_SSQ + 2048;
static_assert(HG_LDS <= RING_BYTES, "hgrn2 lds");
__device__ __forceinline__ bf16x8 cat44(bf16x4 a, bf16x4 b) { return (bf16x8){a[0], a[1], a[2], a[3], b[0], b[1], b[2], b[3]}; }
__device__ __forceinline__ bf16x8 pack8f(f32x4 a, f32x4 b) { v4u p; p.x = pk2(a[0], a[1]); p.y = pk2(a[2], a[3]); p.z = pk2(b[0], b[1]); p.w = pk2(b[2], b[3]); return __builtin_bit_cast(bf16x8, p); }
#define MFMA16(a, b, c) __builtin_amdgcn_mfma_f32_16x16x32_bf16((a), (b), (c), 0, 0, 0)
__device__ __forceinline__ void hgrn2_run(LAS unsigned char* lds, int b, int h, const bf16* QH, const bf16* GL, const bf16* VH, const bf16* GT, const float* norm_g, bf16* YA) {
    int tid_ = threadIdx.x; asm volatile("" : "+v"(tid_)); const int tid = tid_, lane = tid & 63, w = __builtin_amdgcn_readfirstlane(tid >> 6), i16 = lane & 15, g4 = lane >> 4;
    const int k = 16 * w + i16;
    const int n = k;
    LAS float* ssq = (LAS float*)(lds + HG_SSQ);
    const size_t rowbase = (size_t)b * SEQ; const int colbase = h * 128;
    const float ng = norm_g[colbase + n];
    f32x4 S[8];
#pragma unroll
    for (int i = 0; i < 8; ++i) S[i] = (f32x4){0.f, 0.f, 0.f, 0.f};
    unsigned short gr[8], qr[8], vr[8], tr[8], trp[8];
    f32x4 op0 = {0.f, 0.f, 0.f, 0.f}, op1 = op0;
#pragma unroll
    for (int i = 0; i < 8; ++i) { const size_t o = (rowbase + 8 * g4 + i) * HGW + colbase + k; gr[i] = GL[o]; qr[i] = QH[o]; vr[i] = VH[o]; trp[i] = 0; }
#pragma unroll
    for (int i = 0; i < 8; ++i) { const int t = 16 * (i >> 2) + 4 * g4 + (i & 3); tr[i] = GT[(rowbase + t) * HGW + colbase + n]; }
#define HG_FINISH(cc) do { const LAS float* sq_ = ssq + ((cc) & 1) * 256; f32x4 s0 = {0.f, 0.f, 0.f, 0.f}, s1 = s0; \
        _Pragma("unroll") for (int ww = 0; ww < 8; ++ww) { s0 += *(const LAS f32x4*)(sq_ + ww * 32 + 4 * g4); s1 += *(const LAS f32x4*)(sq_ + ww * 32 + 16 + 4 * g4); } \
        _Pragma("unroll") for (int r = 0; r < 4; ++r) { \
            const float y0 = op0[r] * __builtin_amdgcn_rsqf(s0[r] * (1.0f / 128.0f) + RMS_EPS) * ng * bf2f(trp[r]); \
            const float y1 = op1[r] * __builtin_amdgcn_rsqf(s1[r] * (1.0f / 128.0f) + RMS_EPS) * ng * bf2f(trp[4 + r]); \
            YA[(rowbase + (cc) * HG_C + 4 * g4 + r) * HGW + colbase + n] = (unsigned short)f2bf(y0); \
            YA[(rowbase + (cc) * HG_C + 16 + 4 * g4 + r) * HGW + colbase + n] = (unsigned short)f2bf(y1); } } while (0)
    for (int c = 0; c < SEQ / HG_C; ++c) {
        const int t0 = c * HG_C;
        LAS unsigned char* tb = lds + (c & 1) * HG_BUF;
        LAS unsigned short* Qp = (LAS unsigned short*)(tb + HG_QP);
        LAS unsigned short* Kp = (LAS unsigned short*)(tb + HG_KP);
        LAS unsigned short* KpT = (LAS unsigned short*)(tb + HG_KPT);
        LAS unsigned short* VT = (LAS unsigned short*)(tb + HG_VT);
        LAS float* dec = (LAS float*)(tb + HG_DEC);
        const int t1 = (c + 1 < SEQ / HG_C) ? t0 + HG_C : t0;
        unsigned short gr2[8], qr2[8], vr2[8], tr2[8];
#pragma unroll
        for (int i = 0; i < 8; ++i) { const size_t o = (rowbase + t1 + 8 * g4 + i) * HGW + colbase + k; gr2[i] = GL[o]; qr2[i] = QH[o]; vr2[i] = VH[o]; }
#pragma unroll
        for (int i = 0; i < 8; ++i) { const int t = 16 * (i >> 2) + 4 * g4 + (i & 3); tr2[i] = GT[(rowbase + t1 + t) * HGW + colbase + n]; }
        float gl[8], bc[8]; float run = 0.f;
#pragma unroll
        for (int i = 0; i < 8; ++i) { gl[i] = bf2f(gr[i]); run += gl[i]; bc[i] = run; }
        const int runi = __builtin_bit_cast(int, run);
        const float p0 = __builtin_bit_cast(float, __builtin_amdgcn_ds_bpermute(i16 << 2, runi)), p1 = __builtin_bit_cast(float, __builtin_amdgcn_ds_bpermute((16 + i16) << 2, runi));
        const float p2 = __builtin_bit_cast(float, __builtin_amdgcn_ds_bpermute((32 + i16) << 2, runi)), p3 = __builtin_bit_cast(float, __builtin_amdgcn_ds_bpermute((48 + i16) << 2, runi));
        const float pre = (g4 > 0 ? p0 : 0.f) + (g4 > 1 ? p1 : 0.f) + (g4 > 2 ? p2 : 0.f);
        unsigned short kp[8];
#pragma unroll
        for (int i = 0; i < 8; ++i) {
            const float bt = pre + bc[i]; const int t = 8 * g4 + i;
            Qp[t * 136 + k] = (unsigned short)f2bf(bf2f(qr[i]) * __expf(bt));
            const float kk = (1.0f - __expf(gl[i])) * __expf(fminf(-bt, 80.f));
            kp[i] = (unsigned short)f2bf(kk); Kp[t * 136 + k] = kp[i];
        }
        { v4u o; o.x = kp[0] | ((unsigned)kp[1] << 16); o.y = kp[2] | ((unsigned)kp[3] << 16); o.z = kp[4] | ((unsigned)kp[5] << 16); o.w = kp[6] | ((unsigned)kp[7] << 16);
          *(LAS v4u*)(KpT + k * 40 + 8 * g4) = o;
          v4u q; q.x = vr[0] | ((unsigned)vr[1] << 16); q.y = vr[2] | ((unsigned)vr[3] << 16); q.z = vr[4] | ((unsigned)vr[5] << 16); q.w = vr[6] | ((unsigned)vr[7] << 16);
          *(LAS v4u*)(VT + k * 40 + 8 * g4) = q; }
        if (g4 == 3) dec[k] = __expf(((p0 + p1) + (p2 + p3)));
        __syncthreads();
        if (c > 0) HG_FINISH(c - 1);
        f32x4 sc00 = {0.f, 0.f, 0.f, 0.f}, sc01 = sc00, sc11 = sc00;
#pragma unroll
        for (int kk = 0; kk < 4; ++kk) {
            const bf16x8 a0 = *(const LAS bf16x8*)(Kp + i16 * 136 + 32 * kk + 8 * g4), a1 = *(const LAS bf16x8*)(Kp + (16 + i16) * 136 + 32 * kk + 8 * g4);
            const bf16x8 b0 = *(const LAS bf16x8*)(Qp + i16 * 136 + 32 * kk + 8 * g4), b1 = *(const LAS bf16x8*)(Qp + (16 + i16) * 136 + 32 * kk + 8 * g4);
            sc00 = MFMA16(a0, b0, sc00); sc01 = MFMA16(a0, b1, sc01); sc11 = MFMA16(a1, b1, sc11);
        }
#pragma unroll
        for (int r = 0; r < 4; ++r) { const bool keep = (4 * g4 + r) <= i16; sc00[r] = keep ? sc00[r] : 0.f; sc11[r] = keep ? sc11[r] : 0.f; }
        const bf16x8 pa0 = pack8f(sc00, (f32x4){0.f, 0.f, 0.f, 0.f}), pa1 = pack8f(sc01, sc11);
        f32x4 o0 = {0.f, 0.f, 0.f, 0.f}, o1 = o0;
#pragma unroll
        for (int kk = 0; kk < 4; ++kk) {
            const bf16x8 Sb = pack8f(S[2 * kk], S[2 * kk + 1]);
            const bf16x8 qa0 = cat44(*(const LAS bf16x4*)(Qp + i16 * 136 + 32 * kk + 4 * g4), *(const LAS bf16x4*)(Qp + i16 * 136 + 32 * kk + 16 + 4 * g4));
            const bf16x8 qa1 = cat44(*(const LAS bf16x4*)(Qp + (16 + i16) * 136 + 32 * kk + 4 * g4), *(const LAS bf16x4*)(Qp + (16 + i16) * 136 + 32 * kk + 16 + 4 * g4));
            o0 = MFMA16(qa0, Sb, o0); o1 = MFMA16(qa1, Sb, o1);
        }
        { const bf16x8 vb = cat44(*(const LAS bf16x4*)(VT + n * 40 + 4 * g4), *(const LAS bf16x4*)(VT + n * 40 + 16 + 4 * g4));
          o0 = MFMA16(pa0, vb, o0); o1 = MFMA16(pa1, vb, o1); }
        { const bf16x8 vn = *(const LAS bf16x8*)(VT + n * 40 + 8 * g4);
#pragma unroll
          for (int tt = 0; tt < 8; ++tt) { const bf16x8 ka = *(const LAS bf16x8*)(KpT + (16 * tt + i16) * 40 + 8 * g4); S[tt] = MFMA16(ka, vn, S[tt]);
              const f32x4 dv = *(const LAS f32x4*)(dec + 16 * tt + 4 * g4); S[tt] = S[tt] * dv; } }
        f32x4 q0 = o0 * o0, q1 = o1 * o1;
#pragma unroll
        for (int off = 1; off < 16; off <<= 1) {
#pragma unroll
            for (int r = 0; r < 4; ++r) { q0[r] += __shfl_xor(q0[r], off); q1[r] += __shfl_xor(q1[r], off); } }
        if (i16 == 0) { LAS float* sq_ = ssq + (c & 1) * 256; *(LAS f32x4*)(sq_ + w * 32 + 4 * g4) = q0; *(LAS f32x4*)(sq_ + w * 32 + 16 + 4 * g4) = q1; }
        op0 = o0; op1 = o1;
#pragma unroll
        for (int i = 0; i < 8; ++i) { trp[i] = tr[i]; gr[i] = gr2[i]; qr[i] = qr2[i]; vr[i] = vr2[i]; tr[i] = tr2[i]; }
    }
    __syncthreads();
    HG_FINISH(SEQ / HG_C - 1);
    __syncthreads();
#undef HG_FINISH
}
#ifndef PH_MASK
#define PH_MASK 0xfff
#endif
#define PH(k) if constexpr ((PH_MASK >> (k)) & 1)
__device__ unsigned g_bar_word[64];
__device__ __forceinline__ void grid_barrier(unsigned G) {
    asm volatile("s_waitcnt vmcnt(0)" ::: "memory");
    __syncthreads();
    if (threadIdx.x == 0) {
        __builtin_amdgcn_fence(__ATOMIC_RELEASE, "agent");
        asm volatile("s_waitcnt vmcnt(0)" ::: "memory");
        const unsigned old = __hip_atomic_fetch_add(&g_bar_word[0], 1u, __ATOMIC_RELAXED, __HIP_MEMORY_SCOPE_AGENT);
        const unsigned target = (old / G + 1u) * G;
        while ((int)(__hip_atomic_load(&g_bar_word[0], __ATOMIC_RELAXED, __HIP_MEMORY_SCOPE_AGENT) - target) < 0) __builtin_amdgcn_s_sleep(2);
    }
    __syncthreads();
    __builtin_amdgcn_fence(__ATOMIC_ACQUIRE, "agent");
    asm volatile("s_waitcnt vmcnt(0)" ::: "memory");
}
#ifndef P1_REPS
#define P1_REPS 1
#endif
#ifndef DBG_STAGE
#define DBG_STAGE 0
#define PG8_STRICT_NOTE 1
#endif
__device__ __forceinline__ void dbg_copy(const bf16* src, float* out, int G) {
    for (size_t i = (size_t)blockIdx.x * NTHR + threadIdx.x; i < (size_t)T * D / 8; i += (size_t)G * NTHR) {
        const v4u w = *(const v4u*)(src + 8 * i);
        f32x4 a = {bf2f(w.x & 0xffff), bf2f(w.x >> 16), bf2f(w.y & 0xffff), bf2f(w.y >> 16)}, b = {bf2f(w.z & 0xffff), bf2f(w.z >> 16), bf2f(w.w & 0xffff), bf2f(w.w >> 16)};
        *(f32x4*)(out + 8 * i) = a; *(f32x4*)(out + 8 * i + 4) = b; }
}
#define DBG(k, src) do { if constexpr (DBG_STAGE == (k)) { GRID_SYNC(); dbg_copy((const bf16*)(src), args.out, G); return; } } while (0)
#define GRID_SYNC() grid_barrier((unsigned)G)
__global__ void __launch_bounds__(NTHR, 2) fwd_mega(Args args) {
    extern __shared__ __attribute__((aligned(16))) unsigned char lds_raw[];
    cg::grid_group grid = cg::this_grid();
    LAS unsigned char* lds = (LAS unsigned char*)lds_raw;
    const int tid = threadIdx.x; const int G = gridDim.x;
    unsigned char* ws = args.ws;
#ifndef NONCOOP_TEST
    grid.sync();
#endif
    bf16* H = (bf16*)(ws + WS_H);
    bf16* PROJ = (bf16*)(ws + WS_PROJ);
    bf16 *QH = PROJ, *GLF = PROJ + UNIT / 2, *VHB = PROJ + 2 * (UNIT / 2), *GTB = PROJ + 3 * (UNIT / 2), *FQ = PROJ + 4 * (UNIT / 2), *FK = PROJ + 5 * (UNIT / 2), *FV = PROJ + 6 * (UNIT / 2);
    bf16 *GA = PROJ + 7 * (UNIT / 2), *GB = PROJ + 9 * (UNIT / 2);
    bf16* YA = (bf16*)(ws + WS_YA);

    PH(0) p0_prologue(args, lds, G);
    GRID_SYNC();

    DBG(1, H);
#ifdef DELAY_TEST
    { const unsigned long long t0 = __builtin_amdgcn_s_memrealtime(); while (__builtin_amdgcn_s_memrealtime() - t0 < 30000ull) __builtin_amdgcn_s_sleep(8); GRID_SYNC(); }
#endif
    PH(1) for (int it = blockIdx.x; it < BATCH * NHF; it += G) fox_cumsum(args, lds + MISC_OFF, it);
    for (int rep_ = 0; rep_ < P1_REPS; ++rep_) { if (rep_) GRID_SYNC();
    PH(2) {
        pg8::Gemm g{H, (const bf16*)(ws + WS_WIN), T, NPROJ, D}; pg8::StaticOrder S; S.init(T, NPROJ, G, (int)blockIdx.x);
        pg8::EpiProj E{PROJ, args.in[5]};
#ifdef P1_TRIVIAL
        (void)g; (void)S; (void)E;
        for (size_t i = (size_t)blockIdx.x * NTHR + threadIdx.x; i < (size_t)T * D / 8; i += (size_t)G * NTHR) { const v4u w = *(const v4u*)(H + 8 * i); v4u o; o.x = w.x ^ 0x80008000u; o.y = w.y; o.z = w.z ^ 0x80000000u; o.w = w.w; *(v4u*)(GA + 8 * i) = o; }
#else
        pg8::gemm_phase<pg8::EpiProj, pg8::StaticOrder, true, true>(lds, g, S, E);
#endif
    }
    }
    GRID_SYNC();

    DBG(2, GA);
    PH(3) for (int it = blockIdx.x; it < BATCH * 4; it += G) hgrn2_run(lds, it >> 2, it & 3, QH, GLF, VHB, GTB, args.in[6], YA);
    PH(4) {
        unsigned* ctr = (unsigned*)(ws + WS_CTL);
        volatile LAS unsigned* ub = (volatile LAS unsigned*)(lds + MISC_OFF + 64);
        const float* C2 = (const float*)(ws + WS_C2);
        for (;;) {
            if (tid == 0) ub[0] = atomicAdd(ctr, 1u);
            __syncthreads();
            const unsigned u = ub[0];
            __syncthreads();
            if (u >= (unsigned)(BATCH * NHF * 16)) break;
            const int qb = 15 - (int)(u >> 7), ix = (int)(u & 127), bh = ((ix & 15) << 3) | (7 - (ix >> 4));
            attn_body::attn_unit<8>(bh >> 3, bh & 7, qb, (const attn_body::bf16*)FQ, (const attn_body::bf16*)FK, (const attn_body::bf16*)FV, (attn_body::bf16*)FQ, C2 + (size_t)bh * SEQ, (char*)lds_raw);
        }
    }
    GRID_SYNC();

    PH(5) {
        bf16* TMP = (bf16*)(ws + WS_TMP); bf16* MG = (bf16*)(ws + WS_MERGED);
        pg8::StaticOrder S; S.init(T, D, G, (int)blockIdx.x);
        { pg8::Gemm g{YA, (const bf16*)(ws + WS_WA), T, D, HGW}; pg8::EpiGate E{TMP, GA, nullptr}; pg8::gemm_phase<pg8::EpiGate, pg8::StaticOrder, true, true>(lds, g, S, E); }
        { pg8::Gemm g{FQ, (const bf16*)(ws + WS_WB), T, D, HGW}; pg8::EpiGate E{MG, GB, TMP}; pg8::gemm_phase<pg8::EpiGate, pg8::StaticOrder, true, true>(lds, g, S, E); }
    }
    GRID_SYNC();
    DBG(3, ws + WS_MERGED);
    PH(6) {
        pg8::StaticOrder S; S.init(T, D, G, (int)blockIdx.x);
        pg8::Gemm g{(const bf16*)(ws + WS_MERGED), (const bf16*)(ws + WS_WO), T, D, D}; pg8::EpiRes<0> E{args.out, H, ALPHA};
        pg8::gemm_phase<pg8::EpiRes<0>, pg8::StaticOrder, true, true>(lds, g, S, E);
    }
    GRID_SYNC();
    PH(7) ln_pass<true>(args.out, args.in[11], args.in[12], H, nullptr, G);
    GRID_SYNC();
    DBG(5, H);
    PH(8) {
        { pg8::StaticOrder S; S.init(T, FF, G, (int)blockIdx.x); pg8::Gemm g{H, (const bf16*)(ws + WS_WFF1), T, FF, D}; pg8::EpiAct<1> E{(bf16*)(ws + WS_FF1), FF};
          pg8::gemm_phase<pg8::EpiAct<1>, pg8::StaticOrder, true, true>(lds, g, S, E); }
        { pg8::StaticOrder S; S.init(T, D, G, (int)blockIdx.x); pg8::Gemm g{(const bf16*)(ws + WS_PB), (const bf16*)(ws + WS_WP), T, D, PLE}; pg8::EpiAct<0> E{(bf16*)(ws + WS_PE), D};
          pg8::gemm_phase<pg8::EpiAct<0>, pg8::StaticOrder, true, true>(lds, g, S, E); }
    }
    GRID_SYNC();
    DBG(6, ws + WS_PE);
    PH(9) {
        pg8::StaticOrder S; S.init(T, D, G, (int)blockIdx.x);
        { pg8::Gemm g{(const bf16*)(ws + WS_FF1), (const bf16*)(ws + WS_WFF2), T, D, FF}; pg8::EpiRes<0> E{args.out, H, ALPHA}; pg8::gemm_phase<pg8::EpiRes<0>, pg8::StaticOrder, true, true>(lds, g, S, E); }
        { pg8::Gemm g{H, (const bf16*)(ws + WS_WPG), T, D, D}; pg8::EpiRes<1> E{args.out, (const bf16*)(ws + WS_PE), 0.f}; pg8::gemm_phase<pg8::EpiRes<1>, pg8::StaticOrder, true, true>(lds, g, S, E); }
    }
    GRID_SYNC();
    PH(10) ln_pass<false>(args.out, args.in[17], args.in[18], nullptr, args.out, G);
}

extern "C" void kernel_launch(void* const* d_in, const int* in_sizes, int n_in, void* d_out, int out_size, void* d_ws, size_t ws_size, hipStream_t stream) {
    static int grid = 0;
    if (grid == 0) {
        if (n_in != 19 || ws_size < WS_END) { fprintf(stderr, "kernel_launch: unexpected n_in %d / ws %zu\n", n_in, ws_size); grid = -1; return; }
        int dev = 0, cus = 0, per_cu = 0;
        (void)hipGetDevice(&dev); (void)hipDeviceGetAttribute(&cus, hipDeviceAttributeMultiprocessorCount, dev);
        if (hipFuncSetAttribute((const void*)fwd_mega, hipFuncAttributeMaxDynamicSharedMemorySize, LDS_BYTES) != hipSuccess) { fprintf(stderr, "kernel_launch: hipFuncSetAttribute failed\n"); }
        if (hipOccupancyMaxActiveBlocksPerMultiprocessor(&per_cu, (const void*)fwd_mega, NTHR, LDS_BYTES) != hipSuccess || per_cu < 1) { fprintf(stderr, "kernel_launch: occupancy query says %d\n", per_cu); per_cu = 1; }
        (void)hipGetLastError();
        grid = cus * 1;
        if (grid <= 0) grid = 256;
    }
    if (grid < 0) return;
    Args a{};
    for (int i = 0; i < 19; ++i) a.in[i] = (const float*)d_in[i];
    a.out = (float*)d_out; a.ws = (unsigned char*)d_ws;
    void* kargs[] = {&a};
#ifdef NONCOOP_TEST
    hipLaunchKernelGGL(fwd_mega, dim3(grid), dim3(NTHR), LDS_BYTES, stream, a); hipError_t e = hipPeekAtLastError(); (void)kargs;
#else
    hipError_t e = hipLaunchCooperativeKernel((const void*)fwd_mega, dim3(grid), dim3(NTHR), kargs, LDS_BYTES, stream);
#endif
    if (e != hipSuccess) fprintf(stderr, "cooperative launch failed: %s (grid %d)\n", hipGetErrorString(e), grid);
}
```

```cpp
#include <hip/hip_runtime.h>
#include <hip/hip_cooperative_groups.h>
#include <cstdio>
#include <cstdint>
namespace cg = cooperative_groups;
#define PG8_AUX 0
#define PROBE_ACT 4
namespace pg8 {
#define PG8_LAS __attribute__((address_space(3)))
typedef unsigned short bf16_t;
typedef short bf16x8 __attribute__((ext_vector_type(8)));
typedef float f32x4 __attribute__((ext_vector_type(4)));
typedef unsigned u32x4 __attribute__((ext_vector_type(4)));
constexpr int BM = 256, BK = 64, HALF = 128, HTB = HALF * BK * 2  , STAGE_BYTES = 8 * HTB, NXCD = 8, WGM = 8;

__host__ __device__ __forceinline__ int lds_byte(int r, int c) { const int st = (r >> 4) * 2 + (c >> 5), rr = r & 15, cc = c & 31, ob = rr * 64 + cc * 2; return st * 1024 + (ob ^ (((ob >> 9) & 1) << 5)); }
__host__ __device__ __forceinline__ void stage_rc(int b, int& R, int& C) { const int st = b / 1024, sb = b % 1024, swz = sb ^ (((sb >> 9) & 1) << 5); R = (st >> 1) * 16 + swz / 64; C = (st & 1) * 32 + (swz % 64) / 2; }
__host__ __device__ __forceinline__ int perm32(int rho) { const int n = rho >> 4, i = rho & 15; return 8 * (i >> 2) + 4 * n + (i & 3); }

struct Unit { int pm, pn; };
struct Gemm { const bf16_t* A; const bf16_t* Bt; int M, N, K; };

struct StaticOrder {
    int nM, nN, nwg, G, c;
    __host__ __device__ void init(int M, int N, int G_, int c_) { nM = M / BM; nN = N / BM; nwg = nM * nN; G = G_; c = c_; }
    __host__ __device__ bool next(int i, Unit& u) const {
        const long L = (long)i * G + c; if (L >= nwg) return false;
        int wgid = (int)L; { const int q = nwg / NXCD, r = nwg % NXCD, xcd = wgid % NXCD, off = wgid / NXCD; wgid = (xcd < r ? xcd * (q + 1) : r * (q + 1) + (xcd - r) * q) + off; }
        const int nig = WGM * nN, gid = wgid / nig, fm = gid * WGM, gsz = (nM - fm) < WGM ? (nM - fm) : WGM;
        u.pm = fm + ((wgid % nig) % gsz); u.pn = (wgid % nig) / gsz; return true;
    }
    __device__ __forceinline__ void a_ready(const Unit&) const {}
    __device__ __forceinline__ void done(const Unit&) const {}
};

typedef float f32x2_t __attribute__((ext_vector_type(2))); typedef __bf16 bf16x2_t __attribute__((ext_vector_type(2)));
__device__ __forceinline__ unsigned cvt_pk_bf16(float lo, float hi) { f32x2_t v = {lo, hi}; bf16x2_t b = __builtin_convertvector(v, bf16x2_t); return __builtin_bit_cast(unsigned, b); }
__device__ __forceinline__ float sigmoidf_(float x) { return __builtin_amdgcn_rcpf(1.0f + __expf(-x)); }
__device__ __forceinline__ float bflo(unsigned w) { return __uint_as_float(w << 16); }
__device__ __forceinline__ float bfhi(unsigned w) { return __uint_as_float(w & 0xffff0000u); }
#define PG8_TILE_BEGIN \
    _Pragma("unroll") for (int ai = 0; ai < 2; ++ai) _Pragma("unroll") for (int m = 0; m < 4; ++m) _Pragma("unroll") for (int bj = 0; bj < 2; ++bj) { \
        const int row = u.pm * BM + ai * HALF + wr * 64 + m * 16 + fr; const int ct = bj * HALF + wc * 32 + 8 * fq; f32x4 v0 = acc[ai][bj][m][0], v1 = acc[ai][bj][m][1];
#define PG8_TILE_END }
#define PG8_EPI_IDS int l_ = threadIdx.x; asm volatile("" : "+v"(l_)); const int fr = l_ & 15, fq = (l_ >> 4) & 3; const int wv_ = __builtin_amdgcn_readfirstlane(l_ >> 6), wr = wv_ >> 2, wc = wv_ & 3;

constexpr size_t UNIT_ELEMS = (size_t)65536 * 512;
constexpr float ATT_C2 = 0.125f * 1.4426950408889634f;
struct EpiProj {
    static constexpr bool PERM = true, AFTER_DRAIN = false;
    bf16_t* base;
    const float* hg_lb;
    template <int ACT> __device__ __forceinline__ void tile(const f32x4 (&acc)[2][2][4][2], const Unit& u, int wr, int wc, int fr, int fq, bf16_t* O, int ldc, int colt, int lbcol) const {
        float lb[2][8];
        if (ACT == 1) {
#pragma unroll
            for (int bj = 0; bj < 2; ++bj)
#pragma unroll
                for (int i = 0; i < 8; ++i) { const int c = lbcol + bj * HALF + wc * 32 + 8 * fq + i; lb[bj][i] = sigmoidf_(hg_lb[c] - hg_lb[512 + c]); }
        }
        PG8_TILE_BEGIN {
            float x[8] = {v0[0], v0[1], v0[2], v0[3], v1[0], v1[1], v1[2], v1[3]};
#pragma unroll
            for (int i = 0; i < 8; ++i) {
                if (ACT == 0) x[i] = x[i] * sigmoidf_(x[i]);
                else if (ACT == 1) { const float l = lb[bj][i]; x[i] = __logf(l + (1.0f - l) * sigmoidf_(x[i])); }
                else if (ACT == 3) x[i] = x[i] * ATT_C2;
                else if (ACT == 4) x[i] = sigmoidf_(x[i]);
            }
            u32x4 w; w.x = cvt_pk_bf16(x[0], x[1]); w.y = cvt_pk_bf16(x[2], x[3]); w.z = cvt_pk_bf16(x[4], x[5]); w.w = cvt_pk_bf16(x[6], x[7]);
            *(u32x4*)(O + (size_t)row * ldc + colt + ct) = w;
        } PG8_TILE_END
    }
    __device__ __forceinline__ void operator()(const f32x4 (&acc)[2][2][4][2], const Unit& u, int, int, int, int) const {
        PG8_EPI_IDS
        const int pn = u.pn;
        if (pn < 14) { const int g = pn >> 1; bf16_t* O = base + (size_t)g * UNIT_ELEMS; const int colt = (pn & 1) * 256;
            if (g == 0 || g == 3) tile<0>(acc, u, wr, wc, fr, fq, O, 512, colt, 0);
            else if (g == 1) tile<1>(acc, u, wr, wc, fr, fq, O, 512, colt, colt);
            else if (g == 4) tile<3>(acc, u, wr, wc, fr, fq, O, 512, colt, 0);
            else tile<2>(acc, u, wr, wc, fr, fq, O, 512, colt, 0);
        } else { const int g = (pn - 14) >> 2; bf16_t* O = base + (size_t)(7 + 2 * g) * UNIT_ELEMS; tile<PROBE_ACT>(acc, u, wr, wc, fr, fq, O, 1024, ((pn - 14) & 3) * 256, 0); }
    }
};
template <int ACT> struct EpiAct {
    static constexpr bool PERM = true, AFTER_DRAIN = false;
    bf16_t* O; int ldc;
    __device__ __forceinline__ void operator()(const f32x4 (&acc)[2][2][4][2], const Unit& u, int, int, int, int) const {
        PG8_EPI_IDS
        const int colt = u.pn * BM;
        PG8_TILE_BEGIN {
            if (ACT == 1) { v0 = __builtin_elementwise_max(v0, (f32x4){0.f, 0.f, 0.f, 0.f}); v1 = __builtin_elementwise_max(v1, (f32x4){0.f, 0.f, 0.f, 0.f}); v0 = v0 * v0; v1 = v1 * v1; }
            u32x4 w; w.x = cvt_pk_bf16(v0[0], v0[1]); w.y = cvt_pk_bf16(v0[2], v0[3]); w.z = cvt_pk_bf16(v1[0], v1[1]); w.w = cvt_pk_bf16(v1[2], v1[3]);
            *(u32x4*)(O + (size_t)row * ldc + colt + ct) = w;
        } PG8_TILE_END
    }
};
template <int SIG = 0> struct EpiGateT {
    static constexpr bool PERM = true, AFTER_DRAIN = false;
    bf16_t* O; const bf16_t* gate; const bf16_t* add;
    __device__ __forceinline__ void operator()(const f32x4 (&acc)[2][2][4][2], const Unit& u, int, int, int, int) const {
        PG8_EPI_IDS
        const int colt = u.pn * BM;
        PG8_TILE_BEGIN {
            const size_t off = (size_t)row * 1024 + colt + ct;
            const u32x4 g = *(const u32x4*)(gate + off);
            if (SIG) {
#pragma unroll
                for (int i = 0; i < 4; ++i) { v0[i] = sigmoidf_(v0[i]); v1[i] = sigmoidf_(v1[i]); } }
            float x[8] = {v0[0] * bflo(g.x), v0[1] * bfhi(g.x), v0[2] * bflo(g.y), v0[3] * bfhi(g.y), v1[0] * bflo(g.z), v1[1] * bfhi(g.z), v1[2] * bflo(g.w), v1[3] * bfhi(g.w)};
            if (add) { const u32x4 a = *(const u32x4*)(add + off);
                x[0] += bflo(a.x); x[1] += bfhi(a.x); x[2] += bflo(a.y); x[3] += bfhi(a.y); x[4] += bflo(a.z); x[5] += bfhi(a.z); x[6] += bflo(a.w); x[7] += bfhi(a.w); }
            u32x4 w; w.x = cvt_pk_bf16(x[0], x[1]); w.y = cvt_pk_bf16(x[2], x[3]); w.z = cvt_pk_bf16(x[4], x[5]); w.w = cvt_pk_bf16(x[6], x[7]);
            *(u32x4*)(O + off) = w;
        } PG8_TILE_END
    }
};
typedef EpiGateT<0> EpiGate;
template <int MODE> struct EpiRes {
    static constexpr bool PERM = true, AFTER_DRAIN = false;
    float* O; const bf16_t* base; float alpha; const bf16_t* base2 = nullptr;
    __device__ __forceinline__ void operator()(const f32x4 (&acc)[2][2][4][2], const Unit& u, int, int, int, int) const {
        PG8_EPI_IDS
        const int colt = u.pn * BM;
        PG8_TILE_BEGIN {
            const size_t off = (size_t)row * 1024 + colt + ct;
            const u32x4 b = *(const u32x4*)(base + off);
            const f32x4 b0 = {bflo(b.x), bfhi(b.x), bflo(b.y), bfhi(b.y)}, b1 = {bflo(b.z), bfhi(b.z), bflo(b.w), bfhi(b.w)};
            f32x4 o0, o1;
            if (MODE == 0) { o0 = b0 * alpha + v0; o1 = b1 * alpha + v1; }
            else if (MODE == 3) { const u32x4 c = *(const u32x4*)(base2 + off);
                o0 = b0 * alpha + v0 + (f32x4){bflo(c.x), bfhi(c.x), bflo(c.y), bfhi(c.y)}; o1 = b1 * alpha + v1 + (f32x4){bflo(c.z), bfhi(c.z), bflo(c.w), bfhi(c.w)}; }
            else { const f32x4 p0 = *(const f32x4*)(O + off), p1 = *(const f32x4*)(O + off + 4);
                f32x4 s0, s1;
#pragma unroll
                for (int i = 0; i < 4; ++i) { s0[i] = sigmoidf_(v0[i]); s1[i] = sigmoidf_(v1[i]); }
                o0 = p0 + s0 * b0; o1 = p1 + s1 * b1; }
            *(f32x4*)(O + off) = o0; *(f32x4*)(O + off + 4) = o1;
        } PG8_TILE_END
    }
};
template <class Epi, class Sched, bool ALIGN_EPI = false, bool SP2 = false>
__device__ __forceinline__ void gemm_phase(PG8_LAS unsigned char* lds, const Gemm g, const Sched& S, const Epi& E) {
    int tid_ = threadIdx.x; asm volatile("" : "+v"(tid_)); const int tid = tid_, wid = __builtin_amdgcn_readfirstlane(tid >> 6), lane = tid & 63, wr = wid >> 2, wc = wid & 3, fr = lane & 15, fq = lane >> 4;
    const int K = g.K, nt = K / BK;
    unsigned voffA[2], voffB[2];
#pragma unroll
    for (int i = 0; i < 2; ++i) { int R, C; stage_rc(tid * 16 + i * 8192, R, C); const int Rb = Epi::PERM ? ((R & ~31) + perm32(R & 31)) : R;
        voffA[i] = (unsigned)(R * K + C) * 2u; voffB[i] = (unsigned)(Rb * K + C) * 2u; }
    const size_t kstep = (size_t)(BK * 2);
    const size_t hstep = (size_t)HALF * K * 2;
    const size_t tstep = 2 * hstep;
    const unsigned ldsw = (unsigned)wid * 1024u;
    const int aoff = lds_byte(wr * 64 + fr, fq * 8), boff = lds_byte(wc * 32 + fr, fq * 8);
#define PG8_SA(b, h) (((b) * 2 + (h)) * HTB)
#define PG8_SB(b, h) ((4 + (b) * 2 + (h)) * HTB)
#define PG8_STAGE(bufoff, gbase, voff) do { _Pragma("unroll") for (int _i = 0; _i < 2; ++_i) \
        __builtin_amdgcn_global_load_lds((const unsigned*)((const char*)(gbase) + (voff)[_i]), (PG8_LAS unsigned*)(lds + (bufoff) + ldsw + _i * 8192), 16, 0, PG8_AUX); } while (0)
#define PG8_LDA(dst, b, h) do { _Pragma("unroll") for (int m = 0; m < 4; ++m) _Pragma("unroll") for (int k = 0; k < 2; ++k) dst[m][k] = *(const PG8_LAS bf16x8*)(lds + PG8_SA(b, h) + aoff + m * 2048 + k * 1024); } while (0)
#define PG8_LDB(dst, b, h) do { _Pragma("unroll") for (int n = 0; n < 2; ++n) _Pragma("unroll") for (int k = 0; k < 2; ++k) dst[n][k] = *(const PG8_LAS bf16x8*)(lds + PG8_SB(b, h) + boff + n * 2048 + k * 1024); } while (0)
#define PG8_MMA(ai, bj, At, Bt) do { __builtin_amdgcn_s_setprio(1); _Pragma("unroll") for (int m = 0; m < 4; ++m) _Pragma("unroll") for (int n = 0; n < 2; ++n) _Pragma("unroll") for (int k = 0; k < 2; ++k) \
        acc[ai][bj][m][n] = __builtin_amdgcn_mfma_f32_16x16x32_bf16(Bt[n][k], At[m][k], acc[ai][bj][m][n], 0, 0, 0); __builtin_amdgcn_s_setprio(0); } while (0)
#ifdef PG8_STRICT
#define PG8_WAIT_V(n) asm volatile("s_waitcnt vmcnt(0)" ::: "memory")
#else
#define PG8_WAIT_V(n) asm volatile("s_waitcnt vmcnt(" #n ")" ::: "memory")
#endif
#define PG8_WAIT_L(n) asm volatile("s_waitcnt lgkmcnt(" #n ")" ::: "memory")
#define PG8_BAR __builtin_amdgcn_s_barrier()
#define PG8_SCHED __builtin_amdgcn_sched_barrier(0)
#ifdef PG8_SIMPLE
    {
        const unsigned lw = ldsw + (unsigned)lane * 16u;
#define PG8_GLD(dst, gbase, voff) do { _Pragma("unroll") for (int _i = 0; _i < 2; ++_i) dst[_i] = *(const u32x4*)((const char*)(gbase) + (voff)[_i]); } while (0)
#define PG8_LST(bufoff, src) do { _Pragma("unroll") for (int _i = 0; _i < 2; ++_i) *(PG8_LAS u32x4*)(lds + (bufoff) + lw + _i * 8192) = src[_i]; } while (0)
        Unit cur_;
        for (int ui_ = 0; S.next(ui_, cur_); ++ui_) {
            f32x4 acc[2][2][4][2];
#pragma unroll
            for (int a = 0; a < 2; ++a)
#pragma unroll
                for (int b = 0; b < 2; ++b)
#pragma unroll
                    for (int m = 0; m < 4; ++m)
#pragma unroll
                        for (int n = 0; n < 2; ++n) acc[a][b][m][n] = (f32x4){0.f, 0.f, 0.f, 0.f};
            bf16x8 At[4][2], B0[2][2], B1[2][2];
            u32x4 rb0[2], rb1[2], ra0[2], ra1[2];
            const char* cA = (const char*)g.A + (size_t)cur_.pm * tstep; const char* cB = (const char*)g.Bt + (size_t)cur_.pn * tstep;
            PG8_GLD(rb0, cB, voffB); PG8_GLD(rb1, cB + hstep, voffB); PG8_GLD(ra0, cA, voffA); PG8_GLD(ra1, cA + hstep, voffA);
            PG8_LST(PG8_SB(0, 0), rb0); PG8_LST(PG8_SB(0, 1), rb1); PG8_LST(PG8_SA(0, 0), ra0); PG8_LST(PG8_SA(0, 1), ra1);
            __syncthreads();
#define PG8_HALFSTEP(B_, NB_, tt) do { \
                const bool more_ = (tt) + 1 < nt; const char* a1 = cA + (size_t)((tt) + 1) * kstep; const char* b1 = cB + (size_t)((tt) + 1) * kstep; \
                if (more_) { PG8_GLD(rb0, b1, voffB); PG8_GLD(rb1, b1 + hstep, voffB); } \
                PG8_LDB(B0, B_, 0); PG8_LDB(B1, B_, 1); PG8_LDA(At, B_, 0); PG8_MMA(0, 0, At, B0); PG8_MMA(0, 1, At, B1); \
                if (more_) { PG8_LST(PG8_SB(NB_, 0), rb0); PG8_LST(PG8_SB(NB_, 1), rb1); PG8_GLD(rb0, a1, voffA); PG8_GLD(rb1, a1 + hstep, voffA); } \
                PG8_LDA(At, B_, 1); PG8_MMA(1, 0, At, B0); PG8_MMA(1, 1, At, B1); \
                if (more_) { PG8_LST(PG8_SA(NB_, 0), rb0); PG8_LST(PG8_SA(NB_, 1), rb1); } \
                __syncthreads(); } while (0)
            for (int t = 0; t < nt; t += 2) { PG8_HALFSTEP(0, 1, t); PG8_HALFSTEP(1, 0, t + 1); }
#undef PG8_HALFSTEP
            E(acc, cur_, wr, wc, fr, fq);
        }
#undef PG8_GLD
#undef PG8_LST
    }
#else
    Unit cur, nxt; int ui = 0;
    if (!S.next(0, cur)) return;
    f32x4 acc[2][2][4][2];
#pragma unroll
    for (int a = 0; a < 2; ++a)
#pragma unroll
        for (int b = 0; b < 2; ++b)
#pragma unroll
            for (int m = 0; m < 4; ++m)
#pragma unroll
                for (int n = 0; n < 2; ++n) acc[a][b][m][n] = (f32x4){0.f, 0.f, 0.f, 0.f};
    bf16x8 At[4][2], B0[2][2], B1[2][2];
    const char* cA = (const char*)g.A + (size_t)cur.pm * tstep; const char* cB = (const char*)g.Bt + (size_t)cur.pn * tstep;
    S.a_ready(cur);
    if constexpr (SP2) {
        PG8_STAGE(PG8_SB(0, 0), cB, voffB); PG8_STAGE(PG8_SB(0, 1), cB + hstep, voffB); PG8_STAGE(PG8_SA(0, 0), cA, voffA); PG8_STAGE(PG8_SA(0, 1), cA + hstep, voffA);
        if (wr == 1) PG8_BAR;
        PG8_WAIT_V(2); PG8_BAR;
        PG8_STAGE(PG8_SB(1, 0), cB + kstep, voffB); PG8_STAGE(PG8_SA(1, 0), cA + kstep, voffA); PG8_STAGE(PG8_SB(1, 1), cB + hstep + kstep, voffB);
        PG8_WAIT_V(6); PG8_BAR;
    } else {
        PG8_STAGE(PG8_SB(0, 0), cB, voffB); PG8_STAGE(PG8_SA(0, 0), cA, voffA); PG8_STAGE(PG8_SB(0, 1), cB + hstep, voffB); PG8_STAGE(PG8_SA(0, 1), cA + hstep, voffA);
        if (wr == 1) PG8_BAR;
        PG8_WAIT_V(4); PG8_BAR;
        PG8_STAGE(PG8_SB(1, 0), cB + kstep, voffB); PG8_STAGE(PG8_SA(1, 0), cA + kstep, voffA); PG8_STAGE(PG8_SB(1, 1), cB + hstep + kstep, voffB);
        PG8_WAIT_V(6); PG8_BAR;
    }
    for (;;) {
        const bool has_next = S.next(ui + 1, nxt);
        const char* nA = has_next ? (const char*)g.A + (size_t)nxt.pm * tstep : cA; const char* nB = has_next ? (const char*)g.Bt + (size_t)nxt.pn * tstep : cB;
        for (int t = 0; t < nt; t += 2) {
            const bool last = (t == nt - 2);
            const char* a1 = cA + (size_t)(t + 1) * kstep;
            const char* a2 = last ? nA : cA + (size_t)(t + 2) * kstep; const char* b2 = last ? nB : cB + (size_t)(t + 2) * kstep;
            const char* a3 = a2 + kstep; const char* b3 = b2 + kstep;
            if (last && has_next) S.a_ready(nxt);
            if constexpr (SP2) {
            PG8_LDB(B0, 0, 0); PG8_LDB(B1, 0, 1); PG8_SCHED; PG8_LDA(At, 0, 0); PG8_STAGE(PG8_SA(1, 1), a1 + hstep, voffA);
            PG8_WAIT_V(8); PG8_WAIT_L(0); PG8_BAR; PG8_MMA(0, 0, At, B0); PG8_MMA(0, 1, At, B1); PG8_BAR; PG8_SCHED;
            PG8_LDA(At, 0, 1); PG8_STAGE(PG8_SB(0, 0), b2, voffB); PG8_STAGE(PG8_SB(0, 1), b2 + hstep, voffB); PG8_STAGE(PG8_SA(0, 0), a2, voffA);
            PG8_WAIT_V(8); PG8_WAIT_L(0); PG8_BAR; PG8_MMA(1, 0, At, B0); PG8_MMA(1, 1, At, B1); PG8_BAR; PG8_SCHED;
            PG8_LDB(B0, 1, 0); PG8_LDB(B1, 1, 1); PG8_SCHED; PG8_LDA(At, 1, 0); PG8_STAGE(PG8_SA(0, 1), a2 + hstep, voffA);
            PG8_WAIT_V(8); PG8_WAIT_L(0); PG8_BAR; PG8_MMA(0, 0, At, B0); PG8_MMA(0, 1, At, B1); PG8_BAR; PG8_SCHED;
            PG8_LDA(At, 1, 1); PG8_STAGE(PG8_SB(1, 0), b3, voffB); PG8_STAGE(PG8_SB(1, 1), b3 + hstep, voffB); PG8_STAGE(PG8_SA(1, 0), a3, voffA);
            PG8_WAIT_V(8); PG8_WAIT_L(0); PG8_BAR; PG8_MMA(1, 0, At, B0); PG8_MMA(1, 1, At, B1); PG8_BAR; PG8_SCHED;
            } else {
            PG8_LDB(B0, 0, 0); PG8_SCHED; PG8_LDA(At, 0, 0); PG8_STAGE(PG8_SA(1, 1), a1 + hstep, voffA);
            PG8_WAIT_L(8); PG8_BAR; PG8_WAIT_L(0); PG8_MMA(0, 0, At, B0); PG8_BAR; PG8_SCHED;
            PG8_LDB(B1, 0, 1); PG8_STAGE(PG8_SB(0, 0), b2, voffB);
            PG8_BAR; PG8_WAIT_L(0); PG8_MMA(0, 1, At, B1); PG8_BAR;
            PG8_LDA(At, 0, 1); PG8_STAGE(PG8_SA(0, 0), a2, voffA);
            PG8_BAR; PG8_WAIT_L(0); PG8_MMA(1, 0, At, B0); PG8_BAR; PG8_SCHED;
            PG8_STAGE(PG8_SB(0, 1), b2 + hstep, voffB);
            PG8_WAIT_V(6); PG8_BAR; PG8_MMA(1, 1, At, B1); PG8_BAR;
            PG8_LDB(B0, 1, 0); PG8_SCHED; PG8_LDA(At, 1, 0); PG8_STAGE(PG8_SA(0, 1), a2 + hstep, voffA);
            PG8_WAIT_L(8); PG8_BAR; PG8_WAIT_L(0); PG8_MMA(0, 0, At, B0); PG8_BAR; PG8_SCHED;
            PG8_LDB(B1, 1, 1); PG8_STAGE(PG8_SB(1, 0), b3, voffB);
            PG8_BAR; PG8_WAIT_L(0); PG8_MMA(0, 1, At, B1); PG8_BAR;
            PG8_LDA(At, 1, 1); PG8_STAGE(PG8_SA(1, 0), a3, voffA);
            PG8_BAR; PG8_WAIT_L(0); PG8_MMA(1, 0, At, B0); PG8_BAR; PG8_SCHED;
            PG8_STAGE(PG8_SB(1, 1), b3 + hstep, voffB);
            PG8_WAIT_V(6); PG8_BAR; PG8_MMA(1, 1, At, B1); PG8_BAR;
            }
        }
        if constexpr (ALIGN_EPI) { if (wr == 0) PG8_BAR; }
        if constexpr (!Epi::AFTER_DRAIN) { E(acc, cur, wr, wc, fr, fq); S.done(cur); }
        if (!has_next) break;
#pragma unroll
        for (int a = 0; a < 2; ++a)
#pragma unroll
            for (int b = 0; b < 2; ++b)
#pragma unroll
                for (int m = 0; m < 4; ++m)
#pragma unroll
                    for (int n = 0; n < 2; ++n) acc[a][b][m][n] = (f32x4){0.f, 0.f, 0.f, 0.f};
        cur = nxt; cA = nA; cB = nB; ++ui;
        if constexpr (ALIGN_EPI) { if (wr == 1) PG8_BAR; }
    }
    PG8_WAIT_V(0);
    if constexpr (!ALIGN_EPI) { if (wr == 0) PG8_BAR; }
    PG8_BAR;
    if constexpr (Epi::AFTER_DRAIN) { E.fused(acc, cur, wr, wc, fr, fq, lds, wid, lane); S.done(cur); }
#endif
#undef PG8_SA
#undef PG8_SB
#undef PG8_STAGE
#undef PG8_LDA
#undef PG8_LDB
#undef PG8_MMA
#undef PG8_WAIT_V
#undef PG8_WAIT_L
#undef PG8_BAR
#undef PG8_SCHED
}
}
#include <hip/hip_bf16.h>
#include <cmath>
namespace attn_body {
using bf16=__hip_bfloat16;
using bf16x8=__attribute__((ext_vector_type(8)))short;
using s16x4=__attribute__((ext_vector_type(4)))short;
using f32x16=__attribute__((ext_vector_type(16)))float;
using u32x4=__attribute__((ext_vector_type(4)))unsigned;
using f32x4v=__attribute__((ext_vector_type(4)))float;
constexpr int BATCH=16,NHEAD=8,SEQ=4096,D=64,DM=NHEAD*D;
constexpr int NW=8,QBLK=32,QB=QBLK*NW,KVBLK=64,NQB=SEQ/QB;
constexpr int ATTN_PITCH=DM, ATTN_UNIT_ROWS=QB;
__device__ __forceinline__ int crow(int r,int hi){return (r&3)+8*(r>>2)+4*hi;}
#define SBAR() __builtin_amdgcn_sched_barrier(0)
__device__ __forceinline__ void cmask(f32x16&p0,f32x16&p1,int jb,int qrel,int hi){
  const float NEG=-INFINITY; int kb=64*jb+4*hi;
  #pragma unroll
  for(int r=0;r<16;++r){int kv=kb+(r&3)+8*(r>>2); if(kv>qrel)p0[r]=NEG; if(kv+32>qrel)p1[r]=NEG;}
}

constexpr int NSLOT=3, SLOTB=8192;
constexpr int LDS_K=0, LDS_V=NSLOT*SLOTB, LDS_WS=2*NSLOT*SLOTB, LDS_OST=LDS_WS+NW*64*4, LDS_CB=LDS_OST+NW*4096, LDS_BYTES=LDS_CB+SEQ*4;
constexpr float FSKIP=100.f;
constexpr float C2=0.125f*1.4426950408889634f;
__device__ __forceinline__ void glds16(const void*gsrc,unsigned lds_dst){unsigned keep;
  asm volatile("s_mov_b32 %0, m0\n\ts_mov_b32 m0, %2\n\ts_nop 0\n\tglobal_load_lds_dwordx4 %1, off\n\ts_mov_b32 m0, %0":"=&s"(keep):"v"(gsrc),"s"(lds_dst):"memory");}
__device__ __forceinline__ float max3f(float a,float b,float c){float r;asm("v_max3_f32 %0, %1, %2, %3":"=v"(r):"v"(a),"v"(b),"v"(c));return r;}
__device__ __forceinline__ float max2f(float a,float b){float r;asm("v_max_f32_e32 %0, %1, %2":"=v"(r):"v"(a),"v"(b));return r;}
__device__ __forceinline__ float fadd_s(float a,float b){float r;asm("v_add_f32_e32 %0, %1, %2":"=v"(r):"v"(a),"v"(b));return r;}
__device__ __forceinline__ float fsub_s(float a,float b){float r;asm("v_sub_f32_e32 %0, %1, %2":"=v"(r):"v"(a),"v"(b));return r;}
typedef float f32x2_t __attribute__((ext_vector_type(2))); typedef __bf16 bf16x2_t __attribute__((ext_vector_type(2)));
__device__ __forceinline__ unsigned cvtpk_s(float lo,float hi){f32x2_t v={lo,hi};bf16x2_t b=__builtin_convertvector(v,bf16x2_t);return __builtin_bit_cast(unsigned,b);}
#define WAIT_BAR(N) asm volatile("s_waitcnt vmcnt(" #N ") lgkmcnt(0)\n\ts_barrier":::"memory")

__device__ __forceinline__ void qkt(f32x16&p0,f32x16&p1,const char*Kslot,const bf16x8*qr,const f32x16&negm,int r32,int hi){
  const char*kb=Kslot+hi*1024+r32*16;
  #pragma unroll
  for(int d0=0;d0<4;++d0){
    const bf16x8 b0=*reinterpret_cast<const bf16x8*>(kb+d0*2048);
    const bf16x8 b1=*reinterpret_cast<const bf16x8*>(kb+d0*2048+512);
    if(d0==0){p0=__builtin_amdgcn_mfma_f32_32x32x16_bf16(b0,qr[0],negm,0,0,0);p1=__builtin_amdgcn_mfma_f32_32x32x16_bf16(b1,qr[0],negm,0,0,0);}
    else{p0=__builtin_amdgcn_mfma_f32_32x32x16_bf16(b0,qr[d0],p0,0,0,0);p1=__builtin_amdgcn_mfma_f32_32x32x16_bf16(b1,qr[d0],p1,0,0,0);}}
}
typedef __attribute__((address_space(3))) const char* lds_cptr;
typedef short v4i16_t __attribute__((ext_vector_type(4)));
__device__ __forceinline__ void kload8(bf16x8*kf,lds_cptr kp){
  kf[0]=*(const __attribute__((address_space(3))) bf16x8*)(kp);      kf[1]=*(const __attribute__((address_space(3))) bf16x8*)(kp+512);
  kf[2]=*(const __attribute__((address_space(3))) bf16x8*)(kp+2048); kf[3]=*(const __attribute__((address_space(3))) bf16x8*)(kp+2560);
  kf[4]=*(const __attribute__((address_space(3))) bf16x8*)(kp+4096); kf[5]=*(const __attribute__((address_space(3))) bf16x8*)(kp+4608);
  kf[6]=*(const __attribute__((address_space(3))) bf16x8*)(kp+6144); kf[7]=*(const __attribute__((address_space(3))) bf16x8*)(kp+6656);
}
__device__ __forceinline__ void kload2(bf16x8*kf,lds_cptr kp,int j){ kf[2*j]=*(const __attribute__((address_space(3))) bf16x8*)(kp+j*2048); kf[2*j+1]=*(const __attribute__((address_space(3))) bf16x8*)(kp+j*2048+512); }
__device__ __forceinline__ s16x4 vtr(lds_cptr p){ return __builtin_bit_cast(s16x4,__builtin_amdgcn_ds_read_tr16_b64_v4i16((__attribute__((address_space(3))) v4i16_t*)p)); }
__device__ __forceinline__ float rowmax(const f32x16&p0,const f32x16&p1){
  float a=max3f(p0[0],p0[1],p1[0]),b=max3f(p0[2],p0[3],p1[1]);a=max3f(a,p1[2],p1[3]);
  #pragma unroll
  for(int r=4;r<16;r+=4){a=max3f(a,p0[r],p0[r+1]);b=max3f(b,p0[r+2],p0[r+3]);a=max3f(a,p1[r],p1[r+1]);b=max3f(b,p1[r+2],p1[r+3]);}
  const float m=max2f(a,b);
  auto rr=__builtin_amdgcn_permlane32_swap(__float_as_uint(m),__float_as_uint(m),false,false);
  return max2f(__uint_as_float(rr[0]),__uint_as_float(rr[1]));
}
__device__ __forceinline__ void pv(f32x16*o,int vb,bf16x8 pa0,bf16x8 pa1,bf16x8 pa2,bf16x8 pa3){
  #pragma unroll
  for(int d0=0;d0<2;++d0){s16x4 lo[4],hi[4];
    #pragma unroll
    for(int ks=0;ks<4;++ks){
      asm volatile("ds_read_b64_tr_b16 %0,%1 offset:%c2":"=&v"(lo[ks]):"v"(vb),"i"(d0*4096+ks*1024):"memory");
      asm volatile("ds_read_b64_tr_b16 %0,%1 offset:%c2":"=&v"(hi[ks]):"v"(vb),"i"(d0*4096+ks*1024+512):"memory");}
    asm volatile("s_waitcnt lgkmcnt(0)":::"memory");SBAR();
    #define PK(k) (bf16x8){lo[k][0],lo[k][1],lo[k][2],lo[k][3],hi[k][0],hi[k][1],hi[k][2],hi[k][3]}
    o[d0]=__builtin_amdgcn_mfma_f32_32x32x16_bf16(pa0,PK(0),o[d0],0,0,0);
    o[d0]=__builtin_amdgcn_mfma_f32_32x32x16_bf16(pa1,PK(1),o[d0],0,0,0);
    o[d0]=__builtin_amdgcn_mfma_f32_32x32x16_bf16(pa2,PK(2),o[d0],0,0,0);
    o[d0]=__builtin_amdgcn_mfma_f32_32x32x16_bf16(pa3,PK(3),o[d0],0,0,0);
    #undef PK
  }
}

#ifndef ATTN_STORE16
#define ATTN_STORE16(p,v) (*(u32x4*)(p)=(v))
#endif
template<int THRL> __device__ __forceinline__ void attn_unit(int b,int h,int qb,const bf16*Q,const bf16*__restrict__ K,const bf16*__restrict__ V,bf16*O,const float*__restrict__ Cbh,char*shm){
  int tid_=threadIdx.x; asm volatile("":"+v"(tid_));
  const int tid=tid_,lane=tid&63,r32=lane&31,hi=lane>>5; const int wid=__builtin_amdgcn_readfirstlane(tid>>6);
  const long rowbase=(long)b*SEQ; const int q0=qb*QB;
  int t0;
  { const int NTf=(q0+QB)/KVBLK; const float cref=Cbh[q0]; const float ce=(lane<NTf)?Cbh[64*lane+63]:cref;
    const unsigned long long sk=__ballot((lane<NTf)&&((cref-ce)<-FSKIP));
    int t_=(int)__builtin_popcountll(sk); t_=(t_<NTf-4?t_:NTf-4)&~1; t0=__builtin_amdgcn_readfirstlane(t_); }
  const bf16*Qw=Q+(rowbase+q0+wid*QBLK)*DM+h*D;
  const bf16*Kh=K+(rowbase+(long)t0*KVBLK)*DM+h*D,*Vh=V+(rowbase+(long)t0*KVBLK)*DM+h*D;
  const unsigned lds0=(unsigned)(uintptr_t)shm;
  float*wsf=(float*)(shm+LDS_WS)+wid*64;
  const bf16*ksrc=Kh+(long)lane*DM+wid*8;
  const bf16*vsrc=Vh+(long)(16*(wid&3)+(lane>>2))*DM+(wid>>2)*32+(lane&3)*8;
  const unsigned kdst=lds0+LDS_K+wid*1024, vdst=lds0+LDS_V+wid*1024;
  #define DMA_K(t,slot) glds16(ksrc+(long)(t)*KVBLK*DM,(unsigned)__builtin_amdgcn_readfirstlane(kdst+(slot)))
  #define DMA_V(t,slot) glds16(vsrc+(long)(t)*KVBLK*DM,(unsigned)__builtin_amdgcn_readfirstlane(vdst+(slot)))
  const int vb0=(int)(lds0+LDS_V)+((lane>>4)&1)*32+(lane&3)*8+(4*hi+((lane&15)>>2))*64;
  const char*Kbase=shm+LDS_K; bf16x8 kf[8];
  const lds_cptr shm3=(lds_cptr)shm; const lds_cptr kp0=shm3+LDS_K+hi*1024+r32*16; const lds_cptr vp0=shm3+LDS_V+((lane>>4)&1)*32+(lane&3)*8+(4*hi+((lane&15)>>2))*64;
  const int NT=(q0+QB)/KVBLK-t0;
  typedef __attribute__((address_space(3))) f32x4v* cb_wptr; typedef __attribute__((address_space(3))) const f32x4v* cb_lptr;
  float cq2;
  { const float c2ref=Cbh[q0]; const int nk4=(q0+QB-t0*KVBLK)>>2; const float*Cs=Cbh+t0*KVBLK; cb_wptr cw=(cb_wptr)((__attribute__((address_space(3))) char*)shm+LDS_CB);
    for(int i=tid;i<nk4;i+=NW*64){ f32x4v v=*(const f32x4v*)(Cs+4*i); v=v-c2ref; cw[i]=v; }
    cq2=Cbh[q0+wid*QBLK+r32]-c2ref;
    asm volatile("s_waitcnt vmcnt(0) lgkmcnt(0)":::"memory"); }
  DMA_K(0,0);DMA_V(0,0);DMA_K(1,SLOTB);
  bf16x8 qr[4];
  #pragma unroll
  for(int d0=0;d0<4;++d0)qr[d0]=*reinterpret_cast<const bf16x8*>(&Qw[(long)r32*DM+d0*16+hi*8]);
  float mhat=0.f,l_reg=0.f;f32x16 o[2];o[0]=f32x16{};o[1]=f32x16{};const f32x16 zz16=f32x16{}; float mq=-cq2;
  const int qrel=wid*QBLK+r32;
  #define CMASK(P0,P1,t) do{int jb_=(t)-(NT-4); if(jb_>=0)cmask(P0,P1,jb_,qrel,hi);}while(0)
  const cb_lptr cb0=(cb_lptr)((__attribute__((address_space(3))) const char*)shm+LDS_CB+hi*16);
  #define BIAS(P0,P1,t) do{ const cb_lptr cp_=cb0+(t)*16; \
    _Pragma("unroll") for(int h_=0;h_<2;++h_){ \
    _Pragma("unroll") for(int j_=2*h_;j_<2*h_+2;++j_){ const f32x4v a_=cp_[2*j_]+mq, b_=cp_[8+2*j_]+mq; \
      P0[4*j_]-=a_[0];P0[4*j_+1]-=a_[1];P0[4*j_+2]-=a_[2];P0[4*j_+3]-=a_[3]; P1[4*j_]-=b_[0];P1[4*j_+1]-=b_[1];P1[4*j_+2]-=b_[2];P1[4*j_+3]-=b_[3]; } SBAR(); } }while(0)
  bool resc=false;
  #define START(P0,P1) do{ const float rm=__builtin_fmaxf(rowmax(P0,P1),0.f); resc=false; \
    { const float dl=rm; mhat=fadd_s(mhat,dl); \
      _Pragma("unroll") for(int r=0;r<16;++r){P0[r]=fsub_s(P0[r],dl);P1[r]=fsub_s(P1[r],dl);} \
      mq=mhat-cq2; } \
    _Pragma("unroll") for(int r=0;r<16;++r)P0[r]=__builtin_amdgcn_exp2f(P0[r]); }while(0)
  #define RESC() do{ if(resc){ asm volatile("s_waitcnt lgkmcnt(0)":::"memory"); \
      _Pragma("unroll") for(int d_=0;d_<2;++d_) _Pragma("unroll") for(int r=0;r<16;++r)o[d_][r]*=wsf[crow(r,hi)]; } }while(0)
  f32x16 pA0,pA1,pB0,pB1;
  int sl_prev=0,sl_cur=0,sl_next=SLOTB;
  #define ROT() do{sl_prev=sl_cur;sl_cur=sl_next;sl_next=(sl_next==(NSLOT-1)*SLOTB)?0:sl_next+SLOTB;}while(0)
  DMA_K(2,2*SLOTB);
  WAIT_BAR(3);
  qkt(pA0,pA1,Kbase,qr,zz16,r32,hi);asm volatile("s_nop 15\n\ts_nop 7":"+v"(pA0),"+v"(pA1));BIAS(pA0,pA1,0);CMASK(pA0,pA1,0);
  START(pA0,pA1);
  _Pragma("unroll") for(int r=0;r<16;++r)pA1[r]=__builtin_amdgcn_exp2f(pA1[r]);
  WAIT_BAR(0);
  DMA_K(3,0);DMA_V(1,SLOTB);
  ROT();
  kload8(kf,kp0+sl_cur);
  WAIT_BAR(2);
  s16x4 vlo[8],vhi[8]; u32x4 pw0,pw1,pw2,pw3;
  #define PKW(P,B) cvtpk_s(P[B],P[B+1])
  #define PAF(k) __builtin_bit_cast(bf16x8,pw##k)
  #define VFR(i) (bf16x8){vlo[i][0],vlo[i][1],vlo[i][2],vlo[i][3],vhi[i][0],vhi[i][1],vhi[i][2],vhi[i][3]}
  #define PIN(x) asm volatile("":"+v"(x))
  #define MX3(a,b,c) __builtin_fmaxf(__builtin_fmaxf((a),(b)),(c))
  #define GAPA(MF,A0,A1,A2,A3,W0,W1,PW) do{ MF; sacc+=A0; sacc+=A1; sacc+=A2; sacc+=A3; PIN(sacc); W0; W1; PIN(PW); SBAR(); }while(0)
  #define EX(v) __builtin_amdgcn_exp2f(v)
  #define GAPB(MF,X,B) do{ MF; X[B]=EX(X[B]); X[B+1]=EX(X[B+1]); X[B+2]=EX(X[B+2]); X[B+3]=EX(X[B+3]); PIN(X); SBAR(); }while(0)
  #define VRD(i) do{ vlo[i]=vtr(vp_+(((i)>>2)*4096+((i)&3)*1024)); vhi[i]=vtr(vp_+(((i)>>2)*4096+((i)&3)*1024+512)); }while(0)
  #define KRD(G,j) do{ if(G){ kload2(kf,kp0+sl_next,j); SBAR(); } }while(0)
  #define STEP(C0,C1,P0,P1,t,GK,GV,GL) do{ SBAR(); \
    const lds_cptr vp_=vp0+sl_prev; \
    VRD(0); SBAR(); float sacc=(P0[0]+P0[1]); \
    GAPA(C0=__builtin_amdgcn_mfma_f32_32x32x16_bf16(kf[0],qr[0],zz16,0,0,0), P0[2],P0[3],P0[4],P0[5],     pw0[0]=PKW(P0,0), pw0[1]=PKW(P0,2), pw0); \
    VRD(4); SBAR(); GAPA(C1=__builtin_amdgcn_mfma_f32_32x32x16_bf16(kf[1],qr[0],zz16,0,0,0), P0[6],P0[7],P0[8],P0[9],     pw0[2]=PKW(P0,4), pw0[3]=PKW(P0,6), pw0); \
    VRD(1); SBAR(); GAPA(C0=__builtin_amdgcn_mfma_f32_32x32x16_bf16(kf[2],qr[1],C0,0,0,0),   P0[10],P0[11],P0[12],P0[13], pw1[0]=PKW(P0,8), pw1[1]=PKW(P0,10), pw1); \
    VRD(5); SBAR(); GAPA(C1=__builtin_amdgcn_mfma_f32_32x32x16_bf16(kf[3],qr[1],C1,0,0,0),   P0[14],P0[15],P1[0],P1[1],   pw1[2]=PKW(P0,12),pw1[3]=PKW(P0,14), pw1); \
    VRD(2); SBAR(); GAPA(C0=__builtin_amdgcn_mfma_f32_32x32x16_bf16(kf[4],qr[2],C0,0,0,0),   P1[2],P1[3],P1[4],P1[5],     pw2[0]=PKW(P1,0), pw2[1]=PKW(P1,2), pw2); \
    VRD(6); SBAR(); GAPA(C1=__builtin_amdgcn_mfma_f32_32x32x16_bf16(kf[5],qr[2],C1,0,0,0),   P1[6],P1[7],P1[8],P1[9],     pw2[2]=PKW(P1,4), pw2[3]=PKW(P1,6), pw2); \
    VRD(3); SBAR(); GAPA(C0=__builtin_amdgcn_mfma_f32_32x32x16_bf16(kf[6],qr[3],C0,0,0,0),   P1[10],P1[11],P1[12],P1[13], pw3[0]=PKW(P1,8), pw3[1]=PKW(P1,10), pw3); \
    VRD(7); SBAR(); GAPA(C1=__builtin_amdgcn_mfma_f32_32x32x16_bf16(kf[7],qr[3],C1,0,0,0),   P1[14],P1[15],0.f,0.f,       pw3[2]=PKW(P1,12),pw3[3]=PKW(P1,14), pw3); \
    l_reg+=sacc; \
    if(GK){DMA_K((t)+3,sl_cur);} if(GV){DMA_V((t)+1,sl_next);} \
    BIAS(C0,C1,t); CMASK(C0,C1,t); \
    { float a=MX3(C0[0],C0[1],C1[0]),b=MX3(C0[2],C0[3],C1[1]); a=MX3(a,C1[2],C1[3]); \
      _Pragma("unroll") for(int r=4;r<16;r+=4){a=MX3(a,C0[r],C0[r+1]);b=MX3(b,C0[r+2],C0[r+3]);a=MX3(a,C1[r],C1[r+1]);b=MX3(b,C1[r+2],C1[r+3]);} \
      float rm=__builtin_fmaxf(a,b); { auto rr=__builtin_amdgcn_permlane32_swap(__float_as_uint(rm),__float_as_uint(rm),false,false); rm=__builtin_fmaxf(__uint_as_float(rr[0]),__uint_as_float(rr[1])); } \
      resc=false; \
      if(__builtin_expect(__any(rm>(float)THRL),0)){ const float dl=__builtin_fmaxf(rm,0.f); mhat+=dl; \
        _Pragma("unroll") for(int r=0;r<16;++r){C0[r]-=dl;C1[r]-=dl;} \
        mq=mhat-cq2; \
        const float f=__builtin_amdgcn_exp2f(-dl); l_reg*=f; if(hi==0)wsf[r32]=f; resc=true; } } \
    SBAR(); \
    GAPB(o[0]=__builtin_amdgcn_mfma_f32_32x32x16_bf16(PAF(0),VFR(0),o[0],0,0,0), C0,0); \
    GAPB(o[1]=__builtin_amdgcn_mfma_f32_32x32x16_bf16(PAF(0),VFR(4),o[1],0,0,0), C0,4); \
    KRD(GL,0); GAPB(o[0]=__builtin_amdgcn_mfma_f32_32x32x16_bf16(PAF(1),VFR(1),o[0],0,0,0), C0,8); \
    KRD(GL,1); GAPB(o[1]=__builtin_amdgcn_mfma_f32_32x32x16_bf16(PAF(1),VFR(5),o[1],0,0,0), C0,12); \
    KRD(GL,2); GAPB(o[0]=__builtin_amdgcn_mfma_f32_32x32x16_bf16(PAF(2),VFR(2),o[0],0,0,0), C1,0); \
    KRD(GL,3); GAPB(o[1]=__builtin_amdgcn_mfma_f32_32x32x16_bf16(PAF(2),VFR(6),o[1],0,0,0), C1,4); \
    GAPB(o[0]=__builtin_amdgcn_mfma_f32_32x32x16_bf16(PAF(3),VFR(3),o[0],0,0,0), C1,8); \
    GAPB(o[1]=__builtin_amdgcn_mfma_f32_32x32x16_bf16(PAF(3),VFR(7),o[1],0,0,0), C1,12); \
    }while(0)
  int t=1;
  #undef CMASK
  #define CMASK(P0,P1,t) do{}while(0)
  for(;t+5<NT;t+=2){
    STEP(pB0,pB1,pA0,pA1,t,true,true,true);     WAIT_BAR(2); RESC(); ROT();
    STEP(pA0,pA1,pB0,pB1,t+1,true,true,true);   WAIT_BAR(2); RESC(); ROT();
  }
  #undef CMASK
  #define CMASK(P0,P1,t) do{int jb_=(t)-(NT-4); if(jb_>=0)cmask(P0,P1,jb_,qrel,hi);}while(0)
  #define ENDW(tt) do{ if((tt)+3<NT){WAIT_BAR(2);} else if((tt)+2<NT){WAIT_BAR(1);} else {WAIT_BAR(0);} }while(0)
  for(;t+1<NT;t+=2){
    STEP(pB0,pB1,pA0,pA1,t,(t+3<NT),(t+1<NT),(t+1<NT));       ENDW(t);   RESC(); ROT();
    STEP(pA0,pA1,pB0,pB1,t+1,(t+4<NT),(t+2<NT),(t+2<NT));     ENDW(t+1); RESC(); ROT();
  }
  STEP(pB0,pB1,pA0,pA1,NT-1,false,false,false); RESC();
  { float sacc=pB0[0]+pB0[1]; _Pragma("unroll") for(int r=2;r<16;++r)sacc+=pB0[r]; _Pragma("unroll") for(int r=0;r<16;++r)sacc+=pB1[r]; l_reg+=sacc;
    pw0=(u32x4){PKW(pB0,0),PKW(pB0,2),PKW(pB0,4),PKW(pB0,6)};pw1=(u32x4){PKW(pB0,8),PKW(pB0,10),PKW(pB0,12),PKW(pB0,14)};pw2=(u32x4){PKW(pB1,0),PKW(pB1,2),PKW(pB1,4),PKW(pB1,6)};pw3=(u32x4){PKW(pB1,8),PKW(pB1,10),PKW(pB1,12),PKW(pB1,14)};
    SBAR(); pv(o,vb0+sl_cur,PAF(0),PAF(1),PAF(2),PAF(3)); }
  #undef PKW
  #undef PAF
  #undef VFR
  #undef PIN
  #undef MX3
  #undef GAPA
  #undef GAPB
  #undef EX
  #undef VRD
  #undef KRD
  #undef STEP
  #undef ENDW
  {auto rr=__builtin_amdgcn_permlane32_swap(__float_as_uint(l_reg),__float_as_uint(l_reg),false,false);l_reg=__uint_as_float(rr[0])+__uint_as_float(rr[1]);}
  if(hi==0)wsf[32+r32]=l_reg;asm volatile("s_waitcnt lgkmcnt(0)":::"memory");
  float rli[16];
  #pragma unroll
  for(int r=0;r<16;++r)rli[r]=__builtin_amdgcn_rcpf(wsf[32+crow(r,hi)]);
  bf16*Ow=O+(rowbase+q0+wid*QBLK)*DM+h*D;
  { bf16*stg=(bf16*)(shm+LDS_OST)+wid*2048;
    #pragma unroll
    for(int r=0;r<16;++r){const int orow=crow(r,hi);
      #pragma unroll
      for(int d0=0;d0<2;++d0)stg[orow*64+d0*32+r32]=__float2bfloat16(o[d0][r]*rli[r]);}
    asm volatile("s_waitcnt lgkmcnt(0)":::"memory");
    #pragma unroll
    for(int i=0;i<4;++i){const int row=i*8+(lane>>3),ch=lane&7; const u32x4 v=*(const u32x4*)(stg+row*64+ch*8); ATTN_STORE16(Ow+(long)row*DM+ch*8,v);} }
  asm volatile("s_waitcnt lgkmcnt(0)\n\ts_barrier":::"memory");
  #undef BIAS
  #undef DMA_K
  #undef DMA_V
  #undef CMASK
  #undef START
  #undef RESC
  #undef ROT
}
constexpr int ATTN_LDS_BYTES=LDS_BYTES;
#undef SBAR
#undef WAIT_BAR
}
#define LAS __attribute__((address_space(3)))
typedef unsigned short bf16;
typedef float f32x4 __attribute__((ext_vector_type(4)));
typedef unsigned v4u __attribute__((ext_vector_type(4)));
typedef unsigned v2u __attribute__((ext_vector_type(2)));
typedef short bf16x8 __attribute__((ext_vector_type(8)));
typedef short bf16x4 __attribute__((ext_vector_type(4)));
constexpr int NWAVES = 8, NTHR = 512;
constexpr int BATCH = 16, SEQ = 4096, T = BATCH * SEQ, D = 1024, FF = 4096, PLE = 256, NIN = 5640, NPROJ = 5632, HGW = 512, NHF = 8;
constexpr float LN_EPS = 1e-5f, RMS_EPS = 1e-6f, ALPHA = 1.189207115002721f, LOG2E = 1.4426950408889634f;
constexpr size_t MiB = 1u << 20, UNIT = 64 * MiB;
constexpr size_t WS_CTL = 0;
constexpr size_t WS_LF = 1 * MiB;
constexpr size_t WS_C2 = 3 * MiB;
constexpr size_t WS_WIN = 6 * MiB;
constexpr size_t WS_WA = 17 * MiB, WS_WB = 18 * MiB, WS_WO = 19 * MiB, WS_WPG = 21 * MiB, WS_WP = 23 * MiB;
constexpr size_t WS_WFF1 = 24 * MiB, WS_WFF2 = 32 * MiB;
constexpr size_t WS_H = 1 * UNIT;
constexpr size_t WS_PROJ = 3 * UNIT;
constexpr size_t WS_YA = 14 * UNIT;
constexpr size_t WS_PB = 15 * UNIT;
constexpr size_t WS_TMP = 3 * UNIT, WS_MERGED = 5 * UNIT;
constexpr size_t WS_FF1 = 3 * UNIT;
constexpr size_t WS_PE = 11 * UNIT;
constexpr size_t WS_END = 16 * UNIT;
constexpr int RING_BYTES = 131072, MISC_OFF = RING_BYTES, LDS_BYTES = 147456;

struct Args { const float* in[19]; float* out; unsigned char* ws; };

__device__ __forceinline__ unsigned f2bf(float f) { unsigned u = __builtin_bit_cast(unsigned, f); return (u + 0x7fffu + ((u >> 16) & 1u)) >> 16; }
__device__ __forceinline__ unsigned pk2(float lo, float hi) { return f2bf(lo) | (f2bf(hi) << 16); }
__device__ __forceinline__ float bf2f(unsigned short h) { return __uint_as_float((unsigned)h << 16); }
__device__ __forceinline__ float wave_sum(float v) {
#pragma unroll
    for (int o = 1; o < 64; o <<= 1) v += __shfl_xor(v, o);
    return v;
}
__device__ __forceinline__ void p0_transpose_item(const float* W, int K, int ldw, int nblk, bf16* WT, LAS float* scr, int item, int lane, int split, int shift) {
    const int kb = item / nblk, nb = item % nblk, k0 = 64 * kb, n0 = 32 * nb; const int s0 = n0 + (n0 >= split ? shift : 0);
#pragma unroll 8
    for (int i = 0; i < 32; ++i) { const int kk = 2 * i + (lane >> 5); scr[kk * 33 + (lane & 31)] = W[(size_t)(k0 + kk) * ldw + s0 + (lane & 31)]; }
    asm volatile("s_waitcnt lgkmcnt(0)" ::: "memory");
    const int c = lane & 7;
#pragma unroll
    for (int j = 0; j < 4; ++j) { const int n = (lane >> 3) + 8 * j; const LAS float* s = scr + (8 * c) * 33 + n;
        v4u o; o.x = pk2(s[0 * 33], s[1 * 33]); o.y = pk2(s[2 * 33], s[3 * 33]); o.z = pk2(s[4 * 33], s[5 * 33]); o.w = pk2(s[6 * 33], s[7 * 33]);
        *(v4u*)(WT + (size_t)(n0 + n) * K + k0 + 8 * c) = o; }
    asm volatile("s_waitcnt lgkmcnt(0)" ::: "memory");
}

__device__ __forceinline__ void p0_prologue(const Args& a, LAS unsigned char* lds, int G) {
    int tid_ = threadIdx.x; asm volatile("" : "+v"(tid_)); const int tid = tid_, lane = tid & 63, wave = __builtin_amdgcn_readfirstlane(tid >> 6);
    unsigned char* ws = a.ws;
    if (blockIdx.x == 0 && tid < 64) ((unsigned*)(ws + WS_CTL))[tid] = 0u;
    const int gw = blockIdx.x * NWAVES + wave, NGW = G * NWAVES;
    const float* w_in = a.in[4];
    {
        LAS float* scr = (LAS float*)(lds + wave * 8704);
        constexpr int I_IN = (D / 64) * (NPROJ / 32), I_A = (HGW / 64) * (D / 32), I_O = (D / 64) * (D / 32), I_F1 = (D / 64) * (FF / 32), I_F2 = (FF / 64) * (D / 32), I_P = (PLE / 64) * (D / 32);
        constexpr int NITEMS = I_IN + 2 * I_A + 2 * I_O + I_F1 + I_F2 + I_P;
        for (int it = gw; it < NITEMS; it += NGW) {
            int r = it;
            if (r < I_IN) { p0_transpose_item(w_in, D, NIN, NPROJ / 32, (bf16*)(ws + WS_WIN), scr, r, lane, 3584, 8); continue; } r -= I_IN;
            if (r < I_A) { p0_transpose_item(a.in[8], HGW, D, D / 32, (bf16*)(ws + WS_WA), scr, r, lane, 1 << 30, 0); continue; } r -= I_A;
            if (r < I_A) { p0_transpose_item(a.in[9], HGW, D, D / 32, (bf16*)(ws + WS_WB), scr, r, lane, 1 << 30, 0); continue; } r -= I_A;
            if (r < I_O) { p0_transpose_item(a.in[10], D, D, D / 32, (bf16*)(ws + WS_WO), scr, r, lane, 1 << 30, 0); continue; } r -= I_O;
            if (r < I_O) { p0_transpose_item(a.in[15], D, D, D / 32, (bf16*)(ws + WS_WPG), scr, r, lane, 1 << 30, 0); continue; } r -= I_O;
            if (r < I_F1) { p0_transpose_item(a.in[13], D, FF, FF / 32, (bf16*)(ws + WS_WFF1), scr, r, lane, 1 << 30, 0); continue; } r -= I_F1;
            if (r < I_F2) { p0_transpose_item(a.in[14], FF, D, D / 32, (bf16*)(ws + WS_WFF2), scr, r, lane, 1 << 30, 0); continue; } r -= I_F2;
            p0_transpose_item(a.in[16], PLE, D, D / 32, (bf16*)(ws + WS_WP), scr, r, lane, 1 << 30, 0);
        }
    }
    __syncthreads();
    LAS float* wf = (LAS float*)lds;
    for (int i = tid; i < D * 8; i += NTHR) wf[i] = w_in[(size_t)(i >> 3) * NIN + 3584 + (i & 7)];
    __syncthreads();
    { const float* p = a.in[1]; bf16* pb = (bf16*)(ws + WS_PB);
      for (size_t i = (size_t)blockIdx.x * NTHR + tid; i < (size_t)T * PLE / 8; i += (size_t)G * NTHR) {
          const f32x4 x0 = *(const f32x4*)(p + 8 * i), x1 = *(const f32x4*)(p + 8 * i + 4);
          v4u o; o.x = pk2(x0.x, x0.y); o.y = pk2(x0.z, x0.w); o.z = pk2(x1.x, x1.y); o.w = pk2(x1.z, x1.w); *(v4u*)(pb + 8 * i) = o; } }
    const float* x = a.in[0]; const float* g0 = a.in[2]; const float* b0 = a.in[3]; const float* fb = a.in[7];
    bf16* H = (bf16*)(ws + WS_H); float* LF = (float*)(ws + WS_LF);
    f32x4 gv[4], bv[4];
#pragma unroll
    for (int j = 0; j < 4; ++j) { gv[j] = *(const f32x4*)(g0 + 256 * j + 4 * lane); bv[j] = *(const f32x4*)(b0 + 256 * j + 4 * lane); }
    for (int m = gw; m < T; m += NGW) {
        const f32x4* xr = (const f32x4*)(x + (size_t)m * D) + lane;
        f32x4 v[4]; float s = 0.f;
#pragma unroll
        for (int j = 0; j < 4; ++j) { v[j] = xr[64 * j]; s += (v[j].x + v[j].y) + (v[j].z + v[j].w); }
        const float mean = wave_sum(s) * (1.f / D); float s2 = 0.f;
#pragma unroll
        for (int j = 0; j < 4; ++j) { v[j] = v[j] - mean; s2 += (v[j].x * v[j].x + v[j].y * v[j].y) + (v[j].z * v[j].z + v[j].w * v[j].w); }
        const float rstd = 1.f / sqrtf(wave_sum(s2) * (1.f / D) + LN_EPS);
        unsigned long long* o8 = (unsigned long long*)(H + (size_t)m * D) + lane;
        float fa[8] = {0.f, 0.f, 0.f, 0.f, 0.f, 0.f, 0.f, 0.f};
#pragma unroll
        for (int j = 0; j < 4; ++j) {
            v[j] = v[j] * rstd * gv[j] + bv[j];
            o8[64 * j] = (unsigned long long)pk2(v[j].x, v[j].y) | ((unsigned long long)pk2(v[j].z, v[j].w) << 32);
#pragma unroll
            for (int e = 0; e < 4; ++e) { const LAS f32x4* wp = (const LAS f32x4*)(wf + (256 * j + 4 * lane + e) * 8); const f32x4 w0 = wp[0], w1 = wp[1]; const float hv = v[j][e];
                fa[0] += hv * w0.x; fa[1] += hv * w0.y; fa[2] += hv * w0.z; fa[3] += hv * w0.w; fa[4] += hv * w1.x; fa[5] += hv * w1.y; fa[6] += hv * w1.z; fa[7] += hv * w1.w; }
        }
        float mine = 0.f;
#pragma unroll
        for (int e = 0; e < 8; ++e) { const float t = wave_sum(fa[e]); if (lane == e) mine = t; }
        if (lane < 8) { const float uu = mine + fb[lane]; const float ls = fminf(uu, 0.f) - log1pf(expf(-fabsf(uu))); LF[(size_t)m * 8 + lane] = ls; }
    }
}
__device__ __forceinline__ void fox_cumsum(const Args& a, LAS unsigned char* lds_misc, int item) {
    int tid_ = threadIdx.x; asm volatile("" : "+v"(tid_)); const int tid = tid_, lane = tid & 63, wave = tid >> 6;
    const int b = item >> 3, hd = item & 7;
    const float* LF = (const float*)(a.ws + WS_LF) + (size_t)b * SEQ * 8 + hd; float* C2 = (float*)(a.ws + WS_C2) + (size_t)item * SEQ;
    float v[8]; float run = 0.f;
#pragma unroll
    for (int i = 0; i < 8; ++i) { run += LF[(size_t)(tid * 8 + i) * 8]; v[i] = run; }
    float inc = run;
#pragma unroll
    for (int o = 1; o < 64; o <<= 1) { const float t = __shfl_up(inc, o); if (lane >= o) inc += t; }
    LAS float* wt = (LAS float*)lds_misc;
    if (lane == 63) wt[wave] = inc;
    __syncthreads();
    float pre = inc - run;
    for (int w = 0; w < wave; ++w) pre += wt[w];
#pragma unroll
    for (int i = 0; i < 8; ++i) C2[tid * 8 + i] = (pre + v[i]) * LOG2E;
    __syncthreads();
}
template <bool TO_BF16> __device__ __forceinline__ void ln_pass(const float* src, const float* gam, const float* bet, bf16* ob, float* of, int G) {
    int tid_ = threadIdx.x; asm volatile("" : "+v"(tid_)); const int tid = tid_, lane = tid & 63, wave = __builtin_amdgcn_readfirstlane(tid >> 6);
    const int gw = blockIdx.x * NWAVES + wave, NGW = G * NWAVES;
    f32x4 gv[4], bv[4];
#pragma unroll
    for (int j = 0; j < 4; ++j) { gv[j] = *(const f32x4*)(gam + 256 * j + 4 * lane); bv[j] = *(const f32x4*)(bet + 256 * j + 4 * lane); }
    for (int m = gw; m < T; m += NGW) {
        const f32x4* xr = (const f32x4*)(src + (size_t)m * D) + lane;
        f32x4 v[4]; float s = 0.f;
#pragma unroll
        for (int j = 0; j < 4; ++j) { v[j] = xr[64 * j]; s += (v[j].x + v[j].y) + (v[j].z + v[j].w); }
        const float mean = wave_sum(s) * (1.f / D); float s2 = 0.f;
#pragma unroll
        for (int j = 0; j < 4; ++j) { v[j] = v[j] - mean; s2 += (v[j].x * v[j].x + v[j].y * v[j].y) + (v[j].z * v[j].z + v[j].w * v[j].w); }
        const float rstd = 1.f / sqrtf(wave_sum(s2) * (1.f / D) + LN_EPS);
#pragma unroll
        for (int j = 0; j < 4; ++j) {
            v[j] = v[j] * rstd * gv[j] + bv[j];
            if (TO_BF16) ((unsigned long long*)(ob + (size_t)m * D) + lane)[64 * j] = (unsigned long long)pk2(v[j].x, v[j].y) | ((unsigned long long)pk2(v[j].z, v[j].w) << 32);
            else ((f32x4*)(of + (size_t)m * D) + lane)[64 * j] = v[j];
        }
    }
}
constexpr int HG_C = 32, HG_QP = 0, HG_KP = 8704, HG_KPT = 17408, HG_VT = 27648, HG_DEC = 37888, HG_BUF = 38400, HG_SSQ = 2 * HG_BUF, HG_LDS = HG_SSQ + 2048;
static_assert(HG_LDS <= RING_BYTES, "hgrn2 lds");
__device__ __forceinline__ bf16x8 cat44(bf16x4 a, bf16x4 b) { return (bf16x8){a[0], a[1], a[2], a[3], b[0], b[1], b[2], b[3]}; }
__device__ __forceinline__ bf16x8 pack8f(f32x4 a, f32x4 b) { v4u p; p.x = pk2(a[0], a[1]); p.y = pk2(a[2], a[3]); p.z = pk2(b[0], b[1]); p.w = pk2(b[2], b[3]); return __builtin_bit_cast(bf16x8, p); }
#define MFMA16(a, b, c) __builtin_amdgcn_mfma_f32_16x16x32_bf16((a), (b), (c), 0, 0, 0)
template <int CTRL> __device__ __forceinline__ float dppf(float v) { return __builtin_bit_cast(float, __builtin_amdgcn_update_dpp(0, __builtin_bit_cast(int, v), CTRL, 0xF, 0xF, true)); }
__device__ __forceinline__ float row16_sum(float v) { v += dppf<0xB1>(v); v += dppf<0x4E>(v); v += dppf<0x141>(v); v += dppf<0x140>(v); return v; }
__device__ __forceinline__ void hgrn2_run(LAS unsigned char* lds, int b, int h, const bf16* QH, const bf16* GL, const bf16* VH, const bf16* GT, const float* norm_g, bf16* YA) {
    int tid_ = threadIdx.x; asm volatile("" : "+v"(tid_)); const int tid = tid_, lane = tid & 63, w = __builtin_amdgcn_readfirstlane(tid >> 6), i16 = lane & 15, g4 = lane >> 4;
    const int k = 16 * w + i16;
    const int n = k;
    LAS float* ssq = (LAS float*)(lds + HG_SSQ);
    const size_t rowbase = (size_t)b * SEQ; const int colbase = h * 128;
    const float ng = norm_g[colbase + n];
    f32x4 S[8];
#pragma unroll
    for (int i = 0; i < 8; ++i) S[i] = (f32x4){0.f, 0.f, 0.f, 0.f};
    unsigned short gr[8], qr[8], vr[8], tr[8], trp[8];
    f32x4 op0 = {0.f, 0.f, 0.f, 0.f}, op1 = op0;
#pragma unroll
    for (int i = 0; i < 8; ++i) { const size_t o = (rowbase + 8 * g4 + i) * HGW + colbase + k; gr[i] = GL[o]; qr[i] = QH[o]; vr[i] = VH[o]; trp[i] = 0; }
#pragma unroll
    for (int i = 0; i < 8; ++i) { const int t = 16 * (i >> 2) + 4 * g4 + (i & 3); tr[i] = GT[(rowbase + t) * HGW + colbase + n]; }
#define HG_FINISH(cc) do { const LAS float* sq_ = ssq + ((cc) & 1) * 256; f32x4 s0 = {0.f, 0.f, 0.f, 0.f}, s1 = s0; \
        _Pragma("unroll") for (int ww = 0; ww < 8; ++ww) { s0 += *(const LAS f32x4*)(sq_ + ww * 32 + 4 * g4); s1 += *(const LAS f32x4*)(sq_ + ww * 32 + 16 + 4 * g4); } \
        _Pragma("unroll") for (int r = 0; r < 4; ++r) { \
            const float y0 = op0[r] * __builtin_amdgcn_rsqf(s0[r] * (1.0f / 128.0f) + RMS_EPS) * ng * bf2f(trp[r]); \
            const float y1 = op1[r] * __builtin_amdgcn_rsqf(s1[r] * (1.0f / 128.0f) + RMS_EPS) * ng * bf2f(trp[4 + r]); \
            YA[(rowbase + (cc) * HG_C + 4 * g4 + r) * HGW + colbase + n] = (unsigned short)f2bf(y0); \
            YA[(rowbase + (cc) * HG_C + 16 + 4 * g4 + r) * HGW + colbase + n] = (unsigned short)f2bf(y1); } } while (0)
    for (int c = 0; c < SEQ / HG_C; ++c) {
        const int t0 = c * HG_C;
        LAS unsigned char* tb = lds + (c & 1) * HG_BUF;
        LAS unsigned short* Qp = (LAS unsigned short*)(tb + HG_QP);
        LAS unsigned short* Kp = (LAS unsigned short*)(tb + HG_KP);
        LAS unsigned short* KpT = (LAS unsigned short*)(tb + HG_KPT);
        LAS unsigned short* VT = (LAS unsigned short*)(tb + HG_VT);
        LAS float* dec = (LAS float*)(tb + HG_DEC);
        const int t1 = (c + 1 < SEQ / HG_C) ? t0 + HG_C : t0;
        unsigned short gr2[8], qr2[8], vr2[8], tr2[8];
#pragma unroll
        for (int i = 0; i < 8; ++i) { const size_t o = (rowbase + t1 + 8 * g4 + i) * HGW + colbase + k; gr2[i] = GL[o]; qr2[i] = QH[o]; vr2[i] = VH[o]; }
#pragma unroll
        for (int i = 0; i < 8; ++i) { const int t = 16 * (i >> 2) + 4 * g4 + (i & 3); tr2[i] = GT[(rowbase + t1 + t) * HGW + colbase + n]; }
        float gl[8], bc[8]; float run = 0.f;
#pragma unroll
        for (int i = 0; i < 8; ++i) { gl[i] = bf2f(gr[i]); run += gl[i]; bc[i] = run; }
        const int runi = __builtin_bit_cast(int, run);
        const float p0 = __builtin_bit_cast(float, __builtin_amdgcn_ds_bpermute(i16 << 2, runi)), p1 = __builtin_bit_cast(float, __builtin_amdgcn_ds_bpermute((16 + i16) << 2, runi));
        const float p2 = __builtin_bit_cast(float, __builtin_amdgcn_ds_bpermute((32 + i16) << 2, runi)), p3 = __builtin_bit_cast(float, __builtin_amdgcn_ds_bpermute((48 + i16) << 2, runi));
        const float pre = (g4 > 0 ? p0 : 0.f) + (g4 > 1 ? p1 : 0.f) + (g4 > 2 ? p2 : 0.f);
        unsigned short kp[8];
#pragma unroll
        for (int i = 0; i < 8; ++i) {
            const float bt = pre + bc[i]; const int t = 8 * g4 + i;
            Qp[t * 136 + k] = (unsigned short)f2bf(bf2f(qr[i]) * __expf(bt));
            const float kk = (1.0f - __expf(gl[i])) * __expf(fminf(-bt, 80.f));
            kp[i] = (unsigned short)f2bf(kk); Kp[t * 136 + k] = kp[i];
        }
        { v4u o; o.x = kp[0] | ((unsigned)kp[1] << 16); o.y = kp[2] | ((unsigned)kp[3] << 16); o.z = kp[4] | ((unsigned)kp[5] << 16); o.w = kp[6] | ((unsigned)kp[7] << 16);
          *(LAS v4u*)(KpT + k * 40 + 8 * g4) = o;
          v4u q; q.x = vr[0] | ((unsigned)vr[1] << 16); q.y = vr[2] | ((unsigned)vr[3] << 16); q.z = vr[4] | ((unsigned)vr[5] << 16); q.w = vr[6] | ((unsigned)vr[7] << 16);
          *(LAS v4u*)(VT + k * 40 + 8 * g4) = q; }
        if (g4 == 3) dec[k] = __expf(((p0 + p1) + (p2 + p3)));
        __syncthreads();
        if (c > 0) HG_FINISH(c - 1);
        f32x4 sc00 = {0.f, 0.f, 0.f, 0.f}, sc01 = sc00, sc11 = sc00;
#pragma unroll
        for (int kk = 0; kk < 4; ++kk) {
            const bf16x8 a0 = *(const LAS bf16x8*)(Kp + i16 * 136 + 32 * kk + 8 * g4), a1 = *(const LAS bf16x8*)(Kp + (16 + i16) * 136 + 32 * kk + 8 * g4);
            const bf16x8 b0 = *(const LAS bf16x8*)(Qp + i16 * 136 + 32 * kk + 8 * g4), b1 = *(const LAS bf16x8*)(Qp + (16 + i16) * 136 + 32 * kk + 8 * g4);
            sc00 = MFMA16(a0, b0, sc00); sc01 = MFMA16(a0, b1, sc01); sc11 = MFMA16(a1, b1, sc11);
        }
#pragma unroll
        for (int r = 0; r < 4; ++r) { const bool keep = (4 * g4 + r) <= i16; sc00[r] = keep ? sc00[r] : 0.f; sc11[r] = keep ? sc11[r] : 0.f; }
        const bf16x8 pa0 = pack8f(sc00, (f32x4){0.f, 0.f, 0.f, 0.f}), pa1 = pack8f(sc01, sc11);
        f32x4 o0 = {0.f, 0.f, 0.f, 0.f}, o1 = o0;
#pragma unroll
        for (int kk = 0; kk < 4; ++kk) {
            const bf16x8 Sb = pack8f(S[2 * kk], S[2 * kk + 1]);
            const bf16x8 qa0 = cat44(*(const LAS bf16x4*)(Qp + i16 * 136 + 32 * kk + 4 * g4), *(const LAS bf16x4*)(Qp + i16 * 136 + 32 * kk + 16 + 4 * g4));
            const bf16x8 qa1 = cat44(*(const LAS bf16x4*)(Qp + (16 + i16) * 136 + 32 * kk + 4 * g4), *(const LAS bf16x4*)(Qp + (16 + i16) * 136 + 32 * kk + 16 + 4 * g4));
            o0 = MFMA16(qa0, Sb, o0); o1 = MFMA16(qa1, Sb, o1);
        }
        { const bf16x8 vb = cat44(*(const LAS bf16x4*)(VT + n * 40 + 4 * g4), *(const LAS bf16x4*)(VT + n * 40 + 16 + 4 * g4));
          o0 = MFMA16(pa0, vb, o0); o1 = MFMA16(pa1, vb, o1); }
        { const bf16x8 vn = *(const LAS bf16x8*)(VT + n * 40 + 8 * g4);
#pragma unroll
          for (int tt = 0; tt < 8; ++tt) { const bf16x8 ka = *(const LAS bf16x8*)(KpT + (16 * tt + i16) * 40 + 8 * g4); S[tt] = MFMA16(ka, vn, S[tt]);
              const f32x4 dv = *(const LAS f32x4*)(dec + 16 * tt + 4 * g4); S[tt] = S[tt] * dv; } }
        f32x4 q0 = o0 * o0, q1 = o1 * o1;
#pragma unroll
        for (int r = 0; r < 4; ++r) { q0[r] = row16_sum(q0[r]); q1[r] = row16_sum(q1[r]); }
        if (i16 == 0) { LAS float* sq_ = ssq + (c & 1) * 256; *(LAS f32x4*)(sq_ + w * 32 + 4 * g4) = q0; *(LAS f32x4*)(sq_ + w * 32 + 16 + 4 * g4) = q1; }
        op0 = o0; op1 = o1;
#pragma unroll
        for (int i = 0; i < 8; ++i) { trp[i] = tr[i]; gr[i] = gr2[i]; qr[i] = qr2[i]; vr[i] = vr2[i]; tr[i] = tr2[i]; }
    }
    __syncthreads();
    HG_FINISH(SEQ / HG_C - 1);
    __syncthreads();
#undef HG_FINISH
}
#ifndef PH_MASK
#define PH_MASK 0xfff
#endif
#define PH(k) if constexpr ((PH_MASK >> (k)) & 1)
__device__ unsigned g_bar_word[64];
__device__ __forceinline__ void grid_barrier(unsigned G) {
    asm volatile("s_waitcnt vmcnt(0)" ::: "memory");
    __syncthreads();
    if (threadIdx.x == 0) {
        __builtin_amdgcn_fence(__ATOMIC_RELEASE, "agent");
        asm volatile("s_waitcnt vmcnt(0)" ::: "memory");
        const unsigned old = __hip_atomic_fetch_add(&g_bar_word[0], 1u, __ATOMIC_RELAXED, __HIP_MEMORY_SCOPE_AGENT);
        const unsigned target = (old / G + 1u) * G;
        while ((int)(__hip_atomic_load(&g_bar_word[0], __ATOMIC_RELAXED, __HIP_MEMORY_SCOPE_AGENT) - target) < 0) __builtin_amdgcn_s_sleep(2);
    }
    __syncthreads();
    __builtin_amdgcn_fence(__ATOMIC_ACQUIRE, "agent");
    asm volatile("s_waitcnt vmcnt(0)" ::: "memory");
}
#ifndef P1_REPS
#define P1_REPS 1
#endif
#ifndef DBG_STAGE
#define DBG_STAGE 0
#define PG8_STRICT_NOTE 1
#endif
__device__ __forceinline__ void dbg_copy(const bf16* src, float* out, int G) {
    for (size_t i = (size_t)blockIdx.x * NTHR + threadIdx.x; i < (size_t)T * D / 8; i += (size_t)G * NTHR) {
        const v4u w = *(const v4u*)(src + 8 * i);
        f32x4 a = {bf2f(w.x & 0xffff), bf2f(w.x >> 16), bf2f(w.y & 0xffff), bf2f(w.y >> 16)}, b = {bf2f(w.z & 0xffff), bf2f(w.z >> 16), bf2f(w.w & 0xffff), bf2f(w.w >> 16)};
        *(f32x4*)(out + 8 * i) = a; *(f32x4*)(out + 8 * i + 4) = b; }
}
#define DBG(k, src) do { if constexpr (DBG_STAGE == (k)) { GRID_SYNC(); dbg_copy((const bf16*)(src), args.out, G); return; } } while (0)
#define GRID_SYNC() grid_barrier((unsigned)G)
__global__ void __launch_bounds__(NTHR, 2) fwd_mega(Args args) {
    extern __shared__ __attribute__((aligned(16))) unsigned char lds_raw[];
    cg::grid_group grid = cg::this_grid();
    LAS unsigned char* lds = (LAS unsigned char*)lds_raw;
    const int tid = threadIdx.x; const int G = gridDim.x;
    unsigned char* ws = args.ws;
#ifndef NONCOOP_TEST
    grid.sync();
#endif
    bf16* H = (bf16*)(ws + WS_H);
    bf16* PROJ = (bf16*)(ws + WS_PROJ);
    bf16 *QH = PROJ, *GLF = PROJ + UNIT / 2, *VHB = PROJ + 2 * (UNIT / 2), *GTB = PROJ + 3 * (UNIT / 2), *FQ = PROJ + 4 * (UNIT / 2), *FK = PROJ + 5 * (UNIT / 2), *FV = PROJ + 6 * (UNIT / 2);
    bf16 *GA = PROJ + 7 * (UNIT / 2), *GB = PROJ + 9 * (UNIT / 2);
    bf16* YA = (bf16*)(ws + WS_YA);

    PH(0) p0_prologue(args, lds, G);
    GRID_SYNC();

    DBG(1, H);
#ifdef DELAY_TEST
    { const unsigned long long t0 = __builtin_amdgcn_s_memrealtime(); while (__builtin_amdgcn_s_memrealtime() - t0 < 30000ull) __builtin_amdgcn_s_sleep(8); GRID_SYNC(); }
#endif
    PH(1) for (int it = blockIdx.x; it < BATCH * NHF; it += G) fox_cumsum(args, lds + MISC_OFF, it);
    for (int rep_ = 0; rep_ < P1_REPS; ++rep_) { if (rep_) GRID_SYNC();
    PH(2) {
        pg8::Gemm g{H, (const bf16*)(ws + WS_WIN), T, NPROJ, D}; pg8::StaticOrder S; S.init(T, NPROJ, G, (int)blockIdx.x);
        pg8::EpiProj E{PROJ, args.in[5]};
#ifdef P1_TRIVIAL
        (void)g; (void)S; (void)E;
        for (size_t i = (size_t)blockIdx.x * NTHR + threadIdx.x; i < (size_t)T * D / 8; i += (size_t)G * NTHR) { const v4u w = *(const v4u*)(H + 8 * i); v4u o; o.x = w.x ^ 0x80008000u; o.y = w.y; o.z = w.z ^ 0x80000000u; o.w = w.w; *(v4u*)(GA + 8 * i) = o; }
#else
        pg8::gemm_phase<pg8::EpiProj, pg8::StaticOrder, true, true>(lds, g, S, E);
#endif
    }
    }
    GRID_SYNC();

    DBG(2, GA);
    PH(3) for (int it = blockIdx.x; it < BATCH * 4; it += G) hgrn2_run(lds, it >> 2, it & 3, QH, GLF, VHB, GTB, args.in[6], YA);
    PH(4) {
        unsigned* ctr = (unsigned*)(ws + WS_CTL);
        volatile LAS unsigned* ub = (volatile LAS unsigned*)(lds + MISC_OFF + 64);
        const float* C2 = (const float*)(ws + WS_C2);
        for (;;) {
            if (tid == 0) ub[0] = atomicAdd(ctr, 1u);
            __syncthreads();
            const unsigned u = ub[0];
            __syncthreads();
            if (u >= (unsigned)(BATCH * NHF * 16)) break;
            const int qb = 15 - (int)(u >> 7), ix = (int)(u & 127), bh = ((ix & 15) << 3) | (7 - (ix >> 4));
            attn_body::attn_unit<8>(bh >> 3, bh & 7, qb, (const attn_body::bf16*)FQ, (const attn_body::bf16*)FK, (const attn_body::bf16*)FV, (attn_body::bf16*)FQ, C2 + (size_t)bh * SEQ, (char*)lds_raw);
        }
    }
    GRID_SYNC();

    PH(5) {
        bf16* TMP = (bf16*)(ws + WS_TMP); bf16* MG = (bf16*)(ws + WS_MERGED);
        pg8::StaticOrder S; S.init(T, D, G, (int)blockIdx.x);
        { pg8::Gemm g{YA, (const bf16*)(ws + WS_WA), T, D, HGW}; pg8::EpiGate E{TMP, GA, nullptr}; pg8::gemm_phase<pg8::EpiGate, pg8::StaticOrder, true, true>(lds, g, S, E); }
        { pg8::Gemm g{FQ, (const bf16*)(ws + WS_WB), T, D, HGW}; pg8::EpiGate E{MG, GB, TMP}; pg8::gemm_phase<pg8::EpiGate, pg8::StaticOrder, true, true>(lds, g, S, E); }
    }
    GRID_SYNC();
    DBG(3, ws + WS_MERGED);
    PH(6) {
        pg8::StaticOrder S; S.init(T, D, G, (int)blockIdx.x);
        pg8::Gemm g{(const bf16*)(ws + WS_MERGED), (const bf16*)(ws + WS_WO), T, D, D}; pg8::EpiRes<0> E{args.out, H, ALPHA};
        pg8::gemm_phase<pg8::EpiRes<0>, pg8::StaticOrder, true, true>(lds, g, S, E);
    }
    GRID_SYNC();
    PH(7) ln_pass<true>(args.out, args.in[11], args.in[12], H, nullptr, G);
    GRID_SYNC();
    DBG(5, H);
    PH(8) {
        { pg8::StaticOrder S; S.init(T, FF, G, (int)blockIdx.x); pg8::Gemm g{H, (const bf16*)(ws + WS_WFF1), T, FF, D}; pg8::EpiAct<1> E{(bf16*)(ws + WS_FF1), FF};
          pg8::gemm_phase<pg8::EpiAct<1>, pg8::StaticOrder, true, true>(lds, g, S, E); }
        { pg8::StaticOrder S; S.init(T, D, G, (int)blockIdx.x); pg8::Gemm g{(const bf16*)(ws + WS_PB), (const bf16*)(ws + WS_WP), T, D, PLE}; pg8::EpiAct<0> E{(bf16*)(ws + WS_PE), D};
          pg8::gemm_phase<pg8::EpiAct<0>, pg8::StaticOrder, true, true>(lds, g, S, E); }
    }
    GRID_SYNC();
    DBG(6, ws + WS_PE);
    PH(9) {
        pg8::StaticOrder S; S.init(T, D, G, (int)blockIdx.x);
        { pg8::Gemm g{H, (const bf16*)(ws + WS_WPG), T, D, D}; pg8::EpiGateT<1> E{(bf16*)(ws + WS_PE), (const bf16*)(ws + WS_PE), nullptr}; pg8::gemm_phase<pg8::EpiGateT<1>, pg8::StaticOrder, true, true>(lds, g, S, E); }
        { pg8::Gemm g{(const bf16*)(ws + WS_FF1), (const bf16*)(ws + WS_WFF2), T, D, FF}; pg8::EpiRes<3> E{args.out, H, ALPHA, (const bf16*)(ws + WS_PE)}; pg8::gemm_phase<pg8::EpiRes<3>, pg8::StaticOrder, true, true>(lds, g, S, E); }
    }
    GRID_SYNC();
    PH(10) ln_pass<false>(args.out, args.in[17], args.in[18], nullptr, args.out, G);
}

extern "C" void kernel_launch(void* const* d_in, const int* in_sizes, int n_in, void* d_out, int out_size, void* d_ws, size_t ws_size, hipStream_t stream) {
    static int grid = 0;
    if (grid == 0) {
        if (n_in != 19 || ws_size < WS_END) { fprintf(stderr, "kernel_launch: unexpected n_in %d / ws %zu\n", n_in, ws_size); grid = -1; return; }
        int dev = 0, cus = 0, per_cu = 0;
        (void)hipGetDevice(&dev); (void)hipDeviceGetAttribute(&cus, hipDeviceAttributeMultiprocessorCount, dev);
        if (hipFuncSetAttribute((const void*)fwd_mega, hipFuncAttributeMaxDynamicSharedMemorySize, LDS_BYTES) != hipSuccess) { fprintf(stderr, "kernel_launch: hipFuncSetAttribute failed\n"); }
        if (hipOccupancyMaxActiveBlocksPerMultiprocessor(&per_cu, (const void*)fwd_mega, NTHR, LDS_BYTES) != hipSuccess || per_cu < 1) { fprintf(stderr, "kernel_launch: occupancy query says %d\n", per_cu); per_cu = 1; }
        (void)hipGetLastError();
        grid = cus * 1;
        if (grid <= 0) grid = 256;
    }
    if (grid < 0) return;
    Args a{};
    for (int i = 0; i < 19; ++i) a.in[i] = (const float*)d_in[i];
    a.out = (float*)d_out; a.ws = (unsigned char*)d_ws;
    void* kargs[] = {&a};
#ifdef NONCOOP_TEST
    hipLaunchKernelGGL(fwd_mega, dim3(grid), dim3(NTHR), LDS_BYTES, stream, a); hipError_t e = hipPeekAtLastError(); (void)kargs;
#else
    hipError_t e = hipLaunchCooperativeKernel((const void*)fwd_mega, dim3(grid), dim3(NTHR), kargs, LDS_BYTES, stream);
#endif
    if (e != hipSuccess) fprintf(stderr, "cooperative launch failed: %s (grid %d)\n", hipGetErrorString(e), grid);
}
```
